# Optimizing an MI355X kernel written in HIP

```python
import jax, jax.numpy as jnp
from jax import lax
import numpy as np

D_MODEL = 4096
BATCH = 1
SEQ = 8192
DEPTH = 1
DEC_BATCH = 8
DEC_SEQ = 64
PAST_LEN = 2048

CHUNK = 64
GMLP_CHUNK = 128
GMLP_GROUP_DIM = 128
GMLP_WIDTH = D_MODEL // 2
GMLP_GROUPS = GMLP_WIDTH // GMLP_GROUP_DIM
V_HEAD_DIM = 128
QK_NOPE_DIM = 128
QK_ROPE_DIM = 64
MLA_HEADS = (D_MODEL - GMLP_WIDTH) // V_HEAD_DIM
MLA_WIDTH = MLA_HEADS * V_HEAD_DIM
MIX_WIDTH = GMLP_WIDTH + MLA_WIDTH
KV_LORA_RANK = 512
Q_LORA_RANK = D_MODEL // 4
D_FF = 256 * ((8 * D_MODEL // 3 + 255) // 256)
N_MOD = 9
QBLOCK = 128
ROPE_THETA = 10000.0
LN_EPS = 1e-5
RMS_EPS = 1e-6
DEEPNORM_ALPHA = (2 * DEPTH) ** 0.25
DEEPNORM_BETA = (8 * DEPTH) ** -0.25
IN_WIDTH = 2 * GMLP_WIDTH + Q_LORA_RANK + KV_LORA_RANK + QK_ROPE_DIM

kernel_name = 'hymba_gmlp_mla_macaron_deepnorm_adaln_stream_step'


def _layernorm(x, g, b):
    xf = x.astype(jnp.float32)
    mu = jnp.mean(xf, axis=-1, keepdims=True)
    var = jnp.mean(jnp.square(xf - mu), axis=-1, keepdims=True)
    y = (xf - mu) * lax.rsqrt(var + LN_EPS) * g.astype(jnp.float32) + b.astype(jnp.float32)
    return y.astype(x.dtype)


def _rmsnorm(x, g):
    xf = x.astype(jnp.float32)
    y = xf * lax.rsqrt(jnp.mean(jnp.square(xf), axis=-1, keepdims=True) + RMS_EPS) * g.astype(jnp.float32)
    return y.astype(x.dtype)


def _rope_tables(pos):
    inv = 1.0 / (ROPE_THETA ** (jnp.arange(0, QK_ROPE_DIM, 2, dtype=jnp.float32) / QK_ROPE_DIM))
    ang = pos.astype(jnp.float32)[:, None] * inv[None, :]
    return jnp.cos(ang), jnp.sin(ang)


def _apply_rope(x, cos, sin):
    x1, x2 = jnp.split(x.astype(jnp.float32), 2, axis=-1)
    return jnp.concatenate([x1 * cos - x2 * sin, x2 * cos + x1 * sin], axis=-1).astype(x.dtype)


def _swiglu(h, w_gate_up, w_down):
    g, u = jnp.split(h @ w_gate_up, 2, axis=-1)
    return (jax.nn.silu(g) * u) @ w_down


def _spatial_gate(u, v_n, w_s, b_s):
    b, s, _ = v_n.shape
    L = min(s, GMLP_CHUNK)
    n = s // L
    vg = v_n.reshape(b, n, L, GMLP_GROUPS, GMLP_GROUP_DIM)
    w = jnp.tril(w_s[:, :L, :L])
    mixed = jnp.einsum('gts,bnsgc->bntgc', w, vg) + b_s[:, :L].T[None, None, :, :, None]
    return u * mixed.reshape(b, s, GMLP_WIDTH)


def _mla_attention(q_nope, q_rope, k_nope, k_rope, v, q_pos, k_pos):
    scale = (QK_NOPE_DIM + QK_ROPE_DIM) ** -0.5
    k_chunk = k_pos // CHUNK

    def block(args):
        qn, qr, qp = args
        s = jnp.einsum('bqhd,bkhd->bhqk', qn, k_nope, preferred_element_type=jnp.float32)
        s = s + jnp.einsum('bqhr,bkr->bhqk', qr, k_rope, preferred_element_type=jnp.float32)
        mask = (qp // CHUNK)[:, None] >= k_chunk[None, :]
        s = jnp.where(mask[None, None], s * scale, -jnp.inf)
        p = jax.nn.softmax(s, axis=-1).astype(v.dtype)
        return jnp.einsum('bhqk,bkhd->bqhd', p, v)

    b, sq = q_nope.shape[:2]
    if sq <= QBLOCK:
        return block((q_nope, q_rope, q_pos))
    nb = sq // QBLOCK

    def to_blocks(t):
        return jnp.moveaxis(t.reshape((b, nb, QBLOCK) + t.shape[2:]), 1, 0)

    out = lax.map(block, (to_blocks(q_nope), to_blocks(q_rope), q_pos.reshape(nb, QBLOCK)))
    return jnp.moveaxis(out, 0, 1).reshape(b, sq, MLA_HEADS, V_HEAD_DIM)


def _mixer(h, pos, cache_latent, cache_krope, w_in, gmlp_ln_g, gmlp_ln_b, gmlp_w_s, gmlp_b_s,
           mla_q_norm_g, mla_w_uq, mla_kv_norm_g, mla_w_ukv, w_out):
    b, s, _ = h.shape
    o1 = GMLP_WIDTH
    o2 = o1 + GMLP_WIDTH
    o3 = o2 + Q_LORA_RANK
    o4 = o3 + KV_LORA_RANK
    u, v, cq, ckv, kr = jnp.split(h @ w_in, [o1, o2, o3, o4], axis=-1)
    v_n = _layernorm(v, gmlp_ln_g, gmlp_ln_b)
    a_out = _spatial_gate(u, v_n, gmlp_w_s, gmlp_b_s)
    cos, sin = _rope_tables(pos)
    q = (_rmsnorm(cq, mla_q_norm_g) @ mla_w_uq).reshape(b, s, MLA_HEADS, QK_NOPE_DIM + QK_ROPE_DIM)
    q_nope = q[..., :QK_NOPE_DIM]
    q_rope = _apply_rope(q[..., QK_NOPE_DIM:], cos[:, None, :], sin[:, None, :])
    lat = _rmsnorm(ckv, mla_kv_norm_g)
    k_rope = _apply_rope(kr, cos, sin)
    if cache_latent is None:
        lat_all, kr_all, k_pos = lat, k_rope, pos
    else:
        lat_all = jnp.concatenate([cache_latent.astype(lat.dtype), lat], axis=1)
        kr_all = jnp.concatenate([cache_krope.astype(k_rope.dtype), k_rope], axis=1)
        k_pos = jnp.arange(lat_all.shape[1], dtype=jnp.int32)
    kv = (lat_all @ mla_w_ukv).reshape(b, lat_all.shape[1], MLA_HEADS, QK_NOPE_DIM + V_HEAD_DIM)
    k_nope, v_h = kv[..., :QK_NOPE_DIM], kv[..., QK_NOPE_DIM:]
    o = _mla_attention(q_nope, q_rope, k_nope, kr_all, v_h, pos, k_pos)
    out = jnp.concatenate([a_out, o.reshape(b, s, MLA_WIDTH)], axis=-1) @ w_out
    return out, lat, k_rope, v_n


def _layer(x, c, pos, cache_latent, cache_krope, w_ada, b_ada, ffn1_w_gate_up, ffn1_w_down,
           ln1_g, ln1_b, w_in, gmlp_ln_g, gmlp_ln_b, gmlp_w_s, gmlp_b_s, mla_q_norm_g, mla_w_uq,
           mla_kv_norm_g, mla_w_ukv, w_out, ln2_g, ln2_b, ffn2_w_gate_up, ffn2_w_down, ln3_g, ln3_b):
    mod = (jax.nn.silu(c) @ w_ada + b_ada)[:, None, :]
    sh1, sc1, g1, sh2, sc2, g2, sh3, sc3, g3 = jnp.split(mod, N_MOD, axis=-1)
    h = x * (1 + sc1) + sh1
    x = _layernorm(DEEPNORM_ALPHA * x + 0.5 * g1 * _swiglu(h, ffn1_w_gate_up, ffn1_w_down), ln1_g, ln1_b)
    h = x * (1 + sc2) + sh2
    m, lat, k_rope, v_n = _mixer(h, pos, cache_latent, cache_krope, w_in, gmlp_ln_g, gmlp_ln_b,
                                 gmlp_w_s, gmlp_b_s, mla_q_norm_g, mla_w_uq, mla_kv_norm_g,
                                 mla_w_ukv, w_out)
    x = _layernorm(DEEPNORM_ALPHA * x + g2 * m, ln2_g, ln2_b)
    h = x * (1 + sc3) + sh3
    x = _layernorm(DEEPNORM_ALPHA * x + 0.5 * g3 * _swiglu(h, ffn2_w_gate_up, ffn2_w_down), ln3_g, ln3_b)
    return x, lat, k_rope, v_n


def setup_inputs(seed: int = 0) -> dict:
    key = jax.random.key(seed)
    ks = jax.random.split(key, 32)

    def nrm(k, shape, scale=1.0):
        return jax.random.normal(k, shape, dtype=jnp.float32) * scale

    d = D_MODEL
    return {
        'x_prompt': nrm(ks[0], (BATCH, SEQ, d)),
        'x_sample': nrm(ks[1], (DEC_BATCH, DEC_SEQ, d)),
        'cache_mla_latent': nrm(ks[2], (DEC_BATCH, PAST_LEN, KV_LORA_RANK)),
        'cache_mla_krope': nrm(ks[3], (DEC_BATCH, PAST_LEN, QK_ROPE_DIM)),
        'c_prompt': nrm(ks[4], (BATCH, d)),
        'c_sample': nrm(ks[5], (DEC_BATCH, d)),
        'w_ada': nrm(ks[6], (d, N_MOD * d), 0.5 * d ** -0.5),
        'b_ada': nrm(ks[7], (N_MOD * d,), 0.02),
        'ffn1_w_gate_up': nrm(ks[8], (d, 2 * D_FF), d ** -0.5),
        'ffn1_w_down': nrm(ks[9], (D_FF, d), DEEPNORM_BETA * D_FF ** -0.5),
        'ln1_g': 1.0 + nrm(ks[10], (d,), 0.02),
        'ln1_b': nrm(ks[11], (d,), 0.02),
        'w_in': nrm(ks[12], (d, IN_WIDTH), d ** -0.5),
        'gmlp_ln_g': 1.0 + nrm(ks[13], (GMLP_WIDTH,), 0.02),
        'gmlp_ln_b': nrm(ks[14], (GMLP_WIDTH,), 0.02),
        'gmlp_w_s': nrm(ks[15], (GMLP_GROUPS, GMLP_CHUNK, GMLP_CHUNK), GMLP_CHUNK ** -0.5),
        'gmlp_b_s': 1.0 + nrm(ks[16], (GMLP_GROUPS, GMLP_CHUNK), 0.02),
        'mla_q_norm_g': 1.0 + nrm(ks[17], (Q_LORA_RANK,), 0.02),
        'mla_w_uq': nrm(ks[18], (Q_LORA_RANK, MLA_HEADS * (QK_NOPE_DIM + QK_ROPE_DIM)), Q_LORA_RANK ** -0.5),
        'mla_kv_norm_g': 1.0 + nrm(ks[19], (KV_LORA_RANK,), 0.02),
        'mla_w_ukv': nrm(ks[20], (KV_LORA_RANK, MLA_HEADS * (QK_NOPE_DIM + V_HEAD_DIM)), KV_LORA_RANK ** -0.5),
        'w_out': nrm(ks[21], (MIX_WIDTH, d), DEEPNORM_BETA * MIX_WIDTH ** -0.5),
        'ln2_g': 1.0 + nrm(ks[22], (d,), 0.02),
        'ln2_b': nrm(ks[23], (d,), 0.02),
        'ffn2_w_gate_up': nrm(ks[24], (d, 2 * D_FF), d ** -0.5),
        'ffn2_w_down': nrm(ks[25], (D_FF, d), DEEPNORM_BETA * D_FF ** -0.5),
        'ln3_g': 1.0 + nrm(ks[26], (d,), 0.02),
        'ln3_b': nrm(ks[27], (d,), 0.02),
    }


def reference(x_prompt, x_sample, cache_mla_latent, cache_mla_krope, c_prompt, c_sample,
              w_ada, b_ada, ffn1_w_gate_up, ffn1_w_down, ln1_g, ln1_b, w_in, gmlp_ln_g, gmlp_ln_b,
              gmlp_w_s, gmlp_b_s, mla_q_norm_g, mla_w_uq, mla_kv_norm_g, mla_w_ukv, w_out,
              ln2_g, ln2_b, ffn2_w_gate_up, ffn2_w_down, ln3_g, ln3_b):
    past = cache_mla_latent.shape[1]
    pos_p = jnp.arange(x_prompt.shape[1], dtype=jnp.int32)
    pos_s = past + jnp.arange(x_sample.shape[1], dtype=jnp.int32)
    y_p, c_lat_p, c_kr_p = x_prompt, None, None
    y_s, c_lat_s, c_kr_s = x_sample, cache_mla_latent, cache_mla_krope
    for _ in range(DEPTH):
        y_p, lat_p, kr_p, _v_p = _layer(
            y_p, c_prompt, pos_p, c_lat_p, c_kr_p, w_ada, b_ada, ffn1_w_gate_up, ffn1_w_down,
            ln1_g, ln1_b, w_in, gmlp_ln_g, gmlp_ln_b, gmlp_w_s, gmlp_b_s, mla_q_norm_g, mla_w_uq,
            mla_kv_norm_g, mla_w_ukv, w_out, ln2_g, ln2_b, ffn2_w_gate_up, ffn2_w_down, ln3_g, ln3_b)
        y_s, lat_s, kr_s, v_s = _layer(
            y_s, c_sample, pos_s, c_lat_s, c_kr_s, w_ada, b_ada, ffn1_w_gate_up, ffn1_w_down,
            ln1_g, ln1_b, w_in, gmlp_ln_g, gmlp_ln_b, gmlp_w_s, gmlp_b_s, mla_q_norm_g, mla_w_uq,
            mla_kv_norm_g, mla_w_ukv, w_out, ln2_g, ln2_b, ffn2_w_gate_up, ffn2_w_down, ln3_g, ln3_b)
    return (y_p, y_s, lat_p, kr_p, lat_s, kr_s, v_s)
```

```cpp
#include <hip/hip_runtime.h>
#include <cstdio>
#include <cstdint>
namespace pg8 {
#define PG8_LAS __attribute__((address_space(3)))
typedef unsigned short bf16_t;
typedef short bf16x8 __attribute__((ext_vector_type(8)));
typedef float f32x4 __attribute__((ext_vector_type(4)));
typedef unsigned u32x4 __attribute__((ext_vector_type(4)));
constexpr int BM = 256, BK = 64, HALF = 128, HTB = HALF * BK * 2  , STAGE_BYTES = 8 * HTB, NXCD = 8, WGM = 8;

__host__ __device__ __forceinline__ int lds_byte(int r, int c) { const int st = (r >> 4) * 2 + (c >> 5), rr = r & 15, cc = c & 31, ob = rr * 64 + cc * 2; return st * 1024 + (ob ^ (((ob >> 9) & 1) << 5)); }
__host__ __device__ __forceinline__ void stage_rc(int b, int& R, int& C) { const int st = b / 1024, sb = b % 1024, swz = sb ^ (((sb >> 9) & 1) << 5); R = (st >> 1) * 16 + swz / 64; C = (st & 1) * 32 + (swz % 64) / 2; }
__host__ __device__ __forceinline__ int perm32(int rho) { const int n = rho >> 4, i = rho & 15; return 8 * (i >> 2) + 4 * n + (i & 3); }

struct Unit { int pm, pn; };
struct Gemm { const bf16_t* A; const bf16_t* Bt; int M, N, K; };

struct StaticOrder {
    int nM, nN, nwg, G, c;
    __host__ __device__ void init(int M, int N, int G_, int c_) { nM = M / BM; nN = N / BM; nwg = nM * nN; G = G_; c = c_; }
    __host__ __device__ bool next(int i, Unit& u) const {
        const long L = (long)i * G + c; if (L >= nwg) return false;
        int wgid = (int)L; { const int q = nwg / NXCD, r = nwg % NXCD, xcd = wgid % NXCD, off = wgid / NXCD; wgid = (xcd < r ? xcd * (q + 1) : r * (q + 1) + (xcd - r) * q) + off; }
        const int nig = WGM * nN, gid = wgid / nig, fm = gid * WGM, gsz = (nM - fm) < WGM ? (nM - fm) : WGM;
        u.pm = fm + ((wgid % nig) % gsz); u.pn = (wgid % nig) / gsz; return true;
    }
    __device__ __forceinline__ void a_ready(const Unit&) const {}
    __device__ __forceinline__ void done(const Unit&) const {}
};

__device__ __forceinline__ unsigned cvt_pk_bf16(float lo, float hi) { unsigned r; asm volatile("v_cvt_pk_bf16_f32 %0, %1, %2" : "=v"(r) : "v"(lo), "v"(hi)); return r; }
typedef float f32x2 __attribute__((ext_vector_type(2)));
typedef unsigned u32x2 __attribute__((ext_vector_type(2)));
constexpr int E_MP = 8192;
constexpr int E_NMOD = 9 * 4096;
__device__ __forceinline__ int e_sidx(int r) { return r < E_MP ? 0 : 1 + ((r - E_MP) >> 6); }
__device__ __forceinline__ int e_pos(int r) { return r < E_MP ? r : 2048 + ((r - E_MP) & 63); }
__device__ __forceinline__ float silu_f(float g) { return g * __builtin_amdgcn_rcpf(1.0f + __builtin_amdgcn_exp2f(-1.4426950408889634f * g)); }

struct EpiSwiglu {
    static constexpr bool PERM = true, AFTER_DRAIN = false;
    bf16_t* O; int ldc;
    __device__ __forceinline__ void operator()(const f32x4 (&acc)[2][2][4][2], const Unit& u, int wr, int wc, int fr, int fq) const {
        const int row0 = u.pm * BM + wr * 64 + fr, col0 = u.pn * HALF + wc * 32 + 8 * fq;
#pragma unroll
        for (int ai = 0; ai < 2; ++ai)
#pragma unroll
            for (int m = 0; m < 4; ++m) {
                bf16_t* rowp = O + (size_t)(row0 + ai * HALF + m * 16) * ldc + col0;
                const f32x4 g0 = acc[ai][0][m][0], g1 = acc[ai][0][m][1], u0 = acc[ai][1][m][0], u1 = acc[ai][1][m][1];
                u32x4 w;
                w.x = cvt_pk_bf16(silu_f(g0[0]) * u0[0], silu_f(g0[1]) * u0[1]); w.y = cvt_pk_bf16(silu_f(g0[2]) * u0[2], silu_f(g0[3]) * u0[3]);
                w.z = cvt_pk_bf16(silu_f(g1[0]) * u1[0], silu_f(g1[1]) * u1[1]); w.w = cvt_pk_bf16(silu_f(g1[2]) * u1[2], silu_f(g1[3]) * u1[3]);
                *(u32x4*)rowp = w;
            }
    }
};
struct EpiResid {
    static constexpr bool PERM = false, AFTER_DRAIN = false;
    const float* Xp; const float* Xs; const float* gate; float* T; float gs;
    __device__ __forceinline__ void operator()(const f32x4 (&acc)[2][2][4][2], const Unit& u, int wr, int wc, int fr, int fq) const {
        const int row0 = u.pm * BM + wr * 64 + fr, col0 = u.pn * BM + wc * 32 + 4 * fq;
#pragma unroll
        for (int ai = 0; ai < 2; ++ai)
#pragma unroll
            for (int m = 0; m < 4; ++m) {
                const int row = row0 + ai * HALF + m * 16;
                const float* xr = (row < E_MP ? Xp + (size_t)row * 4096 : Xs + (size_t)(row - E_MP) * 4096) + col0;
                const float* gr = gate + (size_t)e_sidx(row) * E_NMOD + col0;
                float* tr = T + (size_t)row * 4096 + col0;
#pragma unroll
                for (int bj = 0; bj < 2; ++bj)
#pragma unroll
                    for (int n = 0; n < 2; ++n) {
                        const f32x4 xv = *(const f32x4*)(xr + bj * HALF + n * 16), gv = *(const f32x4*)(gr + bj * HALF + n * 16);
                        *(f32x4*)(tr + bj * HALF + n * 16) = xv * 1.189207115002721f + (gv * gs) * acc[ai][bj][m][n];
                    }
            }
    }
};
struct EpiWin {
    static constexpr bool PERM = false, AFTER_DRAIN = false;
    bf16_t* U; float* Z;
    __device__ __forceinline__ void operator()(const f32x4 (&acc)[2][2][4][2], const Unit& u, int wr, int wc, int fr, int fq) const {
        const int row0 = u.pm * BM + wr * 64 + fr, col0 = u.pn * BM + wc * 32 + 4 * fq;
        if (u.pn < 8) {
#pragma unroll
            for (int ai = 0; ai < 2; ++ai)
#pragma unroll
                for (int m = 0; m < 4; ++m) { bf16_t* rowp = U + (size_t)(row0 + ai * HALF + m * 16) * 2048 + col0;
#pragma unroll
                    for (int bj = 0; bj < 2; ++bj)
#pragma unroll
                        for (int n = 0; n < 2; ++n) { const f32x4 v = acc[ai][bj][m][n]; u32x2 w; w.x = cvt_pk_bf16(v[0], v[1]); w.y = cvt_pk_bf16(v[2], v[3]); *(u32x2*)(rowp + bj * HALF + n * 16) = w; } }
        } else {
#pragma unroll
            for (int ai = 0; ai < 2; ++ai)
#pragma unroll
                for (int m = 0; m < 4; ++m) { float* rowp = Z + (size_t)(row0 + ai * HALF + m * 16) * 3648 + (col0 - 2048);
#pragma unroll
                    for (int bj = 0; bj < 2; ++bj)
#pragma unroll
                        for (int n = 0; n < 2; ++n) if (col0 + bj * HALF + n * 16 < 5696) *(f32x4*)(rowp + bj * HALF + n * 16) = acc[ai][bj][m][n]; }
        }
    }
};
struct EpiHeads {
    static constexpr bool PERM = true, AFTER_DRAIN = false;
    bf16_t* O; float scale; int rope_tile0; const float* rope;
    __device__ __forceinline__ void operator()(const f32x4 (&acc)[2][2][4][2], const Unit& u, int wr, int wc, int fr, int fq) const {
        const int row0 = u.pm * BM + wr * 64 + fr;
        if (u.pn < rope_tile0) {
#pragma unroll
            for (int ai = 0; ai < 2; ++ai)
#pragma unroll
                for (int m = 0; m < 4; ++m) { bf16_t* rowp = O + (size_t)(row0 + ai * HALF + m * 16) * 3072 + wc * 32 + 8 * fq;
#pragma unroll
                    for (int bj = 0; bj < 2; ++bj) { const f32x4 v0 = acc[ai][bj][m][0] * scale, v1 = acc[ai][bj][m][1] * scale; u32x4 w;
                        w.x = cvt_pk_bf16(v0[0], v0[1]); w.y = cvt_pk_bf16(v0[2], v0[3]); w.z = cvt_pk_bf16(v1[0], v1[1]); w.w = cvt_pk_bf16(v1[2], v1[3]);
                        *(u32x4*)(rowp + (2 * u.pn + bj) * 192) = w; } }
        } else {
            const int head = 4 * (u.pn - rope_tile0) + wc, i0 = 8 * fq;
#pragma unroll
            for (int ai = 0; ai < 2; ++ai)
#pragma unroll
                for (int m = 0; m < 4; ++m) { const int row = row0 + ai * HALF + m * 16; const float* rp = rope + (size_t)e_pos(row) * 64 + i0;
                    const f32x4 c0 = *(const f32x4*)rp, c1 = *(const f32x4*)(rp + 4), s0 = *(const f32x4*)(rp + 32), s1 = *(const f32x4*)(rp + 36);
                    const f32x4 a0 = acc[ai][0][m][0], a1 = acc[ai][0][m][1], b0 = acc[ai][1][m][0], b1 = acc[ai][1][m][1];
                    const f32x4 o10 = (a0 * c0 - b0 * s0) * scale, o11 = (a1 * c1 - b1 * s1) * scale, o20 = (b0 * c0 + a0 * s0) * scale, o21 = (b1 * c1 + a1 * s1) * scale;
                    bf16_t* rowp = O + (size_t)row * 3072 + head * 192 + 128 + i0; u32x4 w;
                    w.x = cvt_pk_bf16(o10[0], o10[1]); w.y = cvt_pk_bf16(o10[2], o10[3]); w.z = cvt_pk_bf16(o11[0], o11[1]); w.w = cvt_pk_bf16(o11[2], o11[3]); *(u32x4*)rowp = w;
                    w.x = cvt_pk_bf16(o20[0], o20[1]); w.y = cvt_pk_bf16(o20[2], o20[3]); w.z = cvt_pk_bf16(o21[0], o21[1]); w.w = cvt_pk_bf16(o21[2], o21[3]); *(u32x4*)(rowp + 32) = w; }
        }
    }
};
struct EpiVt {
    static constexpr bool PERM = false, AFTER_DRAIN = false;
    bf16_t* VTP; bf16_t* VTS;
    __device__ __forceinline__ void operator()(const f32x4 (&acc)[2][2][4][2], const Unit& u, int wr, int wc, int fr, int fq) const {
        const int f0 = u.pm * BM + wr * 64 + fr, sw = ((fq & 1) << 1) | (fq >> 1);
#pragma unroll
        for (int bj = 0; bj < 2; ++bj)
#pragma unroll
            for (int n = 0; n < 2; ++n) {
                const int tok = u.pn * BM + bj * HALF + wc * 32 + n * 16;
                bf16_t* base; int stride;
                if (tok < E_MP) { base = VTP + tok + 4 * sw; stride = 8192; }
                else { const int t2 = tok - E_MP, b = t2 / 2112, j = t2 - b * 2112; base = VTS + (size_t)b * 2048 * 2112 + j + 4 * sw; stride = 2112; }
#pragma unroll
                for (int ai = 0; ai < 2; ++ai)
#pragma unroll
                    for (int m = 0; m < 4; ++m) { const f32x4 v = acc[ai][bj][m][n]; u32x2 w; w.x = cvt_pk_bf16(v[0], v[1]); w.y = cvt_pk_bf16(v[2], v[3]);
                        *(u32x2*)(base + (size_t)(f0 + ai * HALF + m * 16) * stride) = w; }
            }
    }
};
template <class Epi, class Sched, bool ALIGN_EPI = false, bool SP2 = false>
__device__ __forceinline__ void gemm_phase(PG8_LAS unsigned char* lds, const Gemm g, const Sched& S, const Epi& E) {
    const int tid = threadIdx.x, wid = __builtin_amdgcn_readfirstlane(tid >> 6), lane = tid & 63, wr = wid >> 2, wc = wid & 3, fr = lane & 15, fq = lane >> 4;
    const int K = g.K, nt = K / BK;
    unsigned voffA[2], voffB[2];
#pragma unroll
    for (int i = 0; i < 2; ++i) { int R, C; stage_rc(tid * 16 + i * 8192, R, C); const int Rb = Epi::PERM ? ((R & ~31) + perm32(R & 31)) : R;
        voffA[i] = (unsigned)(R * K + C) * 2u; voffB[i] = (unsigned)(Rb * K + C) * 2u; }
    const size_t kstep = (size_t)(BK * 2);
    const size_t hstep = (size_t)HALF * K * 2;
    const size_t tstep = 2 * hstep;
    const unsigned ldsw = (unsigned)wid * 1024u;
    const int aoff = lds_byte(wr * 64 + fr, fq * 8), boff = lds_byte(wc * 32 + fr, fq * 8);
#define PG8_SA(b, h) (((b) * 2 + (h)) * HTB)
#define PG8_SB(b, h) ((4 + (b) * 2 + (h)) * HTB)
#define PG8_STAGE(bufoff, gbase, voff) do { _Pragma("unroll") for (int _i = 0; _i < 2; ++_i) \
        __builtin_amdgcn_global_load_lds((const unsigned*)((const char*)(gbase) + (voff)[_i]), (PG8_LAS unsigned*)(lds + (bufoff) + ldsw + _i * 8192), 16, 0, 0); } while (0)
#define PG8_LDA(dst, b, h) do { _Pragma("unroll") for (int m = 0; m < 4; ++m) _Pragma("unroll") for (int k = 0; k < 2; ++k) dst[m][k] = *(const PG8_LAS bf16x8*)(lds + PG8_SA(b, h) + aoff + m * 2048 + k * 1024); } while (0)
#define PG8_LDB(dst, b, h) do { _Pragma("unroll") for (int n = 0; n < 2; ++n) _Pragma("unroll") for (int k = 0; k < 2; ++k) dst[n][k] = *(const PG8_LAS bf16x8*)(lds + PG8_SB(b, h) + boff + n * 2048 + k * 1024); } while (0)
#define PG8_MMA(ai, bj, At, Bt) do { __builtin_amdgcn_s_setprio(1); _Pragma("unroll") for (int m = 0; m < 4; ++m) _Pragma("unroll") for (int n = 0; n < 2; ++n) _Pragma("unroll") for (int k = 0; k < 2; ++k) \
        acc[ai][bj][m][n] = __builtin_amdgcn_mfma_f32_16x16x32_bf16(Bt[n][k], At[m][k], acc[ai][bj][m][n], 0, 0, 0); __builtin_amdgcn_s_setprio(0); } while (0)
#define PG8_WAIT_V(n) asm volatile("s_waitcnt vmcnt(" #n ")" ::: "memory")
#define PG8_WAIT_L(n) asm volatile("s_waitcnt lgkmcnt(" #n ")" ::: "memory")
#define PG8_BAR __builtin_amdgcn_s_barrier()
#define PG8_SCHED __builtin_amdgcn_sched_barrier(0)
    Unit cur, nxt; int ui = 0;
    if (!S.next(0, cur)) return;
    f32x4 acc[2][2][4][2];
#pragma unroll
    for (int a = 0; a < 2; ++a)
#pragma unroll
        for (int b = 0; b < 2; ++b)
#pragma unroll
            for (int m = 0; m < 4; ++m)
#pragma unroll
                for (int n = 0; n < 2; ++n) acc[a][b][m][n] = (f32x4){0.f, 0.f, 0.f, 0.f};
    bf16x8 At[4][2], B0[2][2], B1[2][2];
    const char* cA = (const char*)g.A + (size_t)cur.pm * tstep; const char* cB = (const char*)g.Bt + (size_t)cur.pn * tstep;
    S.a_ready(cur);
    if constexpr (SP2) {
        PG8_STAGE(PG8_SB(0, 0), cB, voffB); PG8_STAGE(PG8_SB(0, 1), cB + hstep, voffB); PG8_STAGE(PG8_SA(0, 0), cA, voffA); PG8_STAGE(PG8_SA(0, 1), cA + hstep, voffA);
        if (wr == 1) PG8_BAR;
        PG8_WAIT_V(2); PG8_BAR;
        PG8_STAGE(PG8_SB(1, 0), cB + kstep, voffB); PG8_STAGE(PG8_SA(1, 0), cA + kstep, voffA); PG8_STAGE(PG8_SB(1, 1), cB + hstep + kstep, voffB);
        PG8_WAIT_V(6); PG8_BAR;
    } else {
        PG8_STAGE(PG8_SB(0, 0), cB, voffB); PG8_STAGE(PG8_SA(0, 0), cA, voffA); PG8_STAGE(PG8_SB(0, 1), cB + hstep, voffB); PG8_STAGE(PG8_SA(0, 1), cA + hstep, voffA);
        if (wr == 1) PG8_BAR;
        PG8_WAIT_V(4); PG8_BAR;
        PG8_STAGE(PG8_SB(1, 0), cB + kstep, voffB); PG8_STAGE(PG8_SA(1, 0), cA + kstep, voffA); PG8_STAGE(PG8_SB(1, 1), cB + hstep + kstep, voffB);
        PG8_WAIT_V(6); PG8_BAR;
    }
    for (;;) {
        const bool has_next = S.next(ui + 1, nxt);
        const char* nA = has_next ? (const char*)g.A + (size_t)nxt.pm * tstep : cA; const char* nB = has_next ? (const char*)g.Bt + (size_t)nxt.pn * tstep : cB;
        for (int t = 0; t < nt; t += 2) {
            const bool last = (t == nt - 2);
            const char* a1 = cA + (size_t)(t + 1) * kstep;
            const char* a2 = last ? nA : cA + (size_t)(t + 2) * kstep; const char* b2 = last ? nB : cB + (size_t)(t + 2) * kstep;
            const char* a3 = a2 + kstep; const char* b3 = b2 + kstep;
            if (last && has_next) S.a_ready(nxt);
            if constexpr (SP2) {
            PG8_LDB(B0, 0, 0); PG8_LDB(B1, 0, 1); PG8_SCHED; PG8_LDA(At, 0, 0); PG8_STAGE(PG8_SA(1, 1), a1 + hstep, voffA);
            PG8_WAIT_V(8); PG8_WAIT_L(0); PG8_BAR; PG8_MMA(0, 0, At, B0); PG8_MMA(0, 1, At, B1); PG8_BAR; PG8_SCHED;
            PG8_LDA(At, 0, 1); PG8_STAGE(PG8_SB(0, 0), b2, voffB); PG8_STAGE(PG8_SB(0, 1), b2 + hstep, voffB); PG8_STAGE(PG8_SA(0, 0), a2, voffA);
            PG8_WAIT_V(8); PG8_WAIT_L(0); PG8_BAR; PG8_MMA(1, 0, At, B0); PG8_MMA(1, 1, At, B1); PG8_BAR; PG8_SCHED;
            PG8_LDB(B0, 1, 0); PG8_LDB(B1, 1, 1); PG8_SCHED; PG8_LDA(At, 1, 0); PG8_STAGE(PG8_SA(0, 1), a2 + hstep, voffA);
            PG8_WAIT_V(8); PG8_WAIT_L(0); PG8_BAR; PG8_MMA(0, 0, At, B0); PG8_MMA(0, 1, At, B1); PG8_BAR; PG8_SCHED;
            PG8_LDA(At, 1, 1); PG8_STAGE(PG8_SB(1, 0), b3, voffB); PG8_STAGE(PG8_SB(1, 1), b3 + hstep, voffB); PG8_STAGE(PG8_SA(1, 0), a3, voffA);
            PG8_WAIT_V(8); PG8_WAIT_L(0); PG8_BAR; PG8_MMA(1, 0, At, B0); PG8_MMA(1, 1, At, B1); PG8_BAR; PG8_SCHED;
            } else {
            PG8_LDB(B0, 0, 0); PG8_SCHED; PG8_LDA(At, 0, 0); PG8_STAGE(PG8_SA(1, 1), a1 + hstep, voffA);
            PG8_WAIT_L(8); PG8_BAR; PG8_WAIT_L(0); PG8_MMA(0, 0, At, B0); PG8_BAR; PG8_SCHED;
            PG8_LDB(B1, 0, 1); PG8_STAGE(PG8_SB(0, 0), b2, voffB);
            PG8_BAR; PG8_WAIT_L(0); PG8_MMA(0, 1, At, B1); PG8_BAR;
            PG8_LDA(At, 0, 1); PG8_STAGE(PG8_SA(0, 0), a2, voffA);
            PG8_BAR; PG8_WAIT_L(0); PG8_MMA(1, 0, At, B0); PG8_BAR; PG8_SCHED;
            PG8_STAGE(PG8_SB(0, 1), b2 + hstep, voffB);
            PG8_WAIT_V(6); PG8_BAR; PG8_MMA(1, 1, At, B1); PG8_BAR;
            PG8_LDB(B0, 1, 0); PG8_SCHED; PG8_LDA(At, 1, 0); PG8_STAGE(PG8_SA(0, 1), a2 + hstep, voffA);
            PG8_WAIT_L(8); PG8_BAR; PG8_WAIT_L(0); PG8_MMA(0, 0, At, B0); PG8_BAR; PG8_SCHED;
            PG8_LDB(B1, 1, 1); PG8_STAGE(PG8_SB(1, 0), b3, voffB);
            PG8_BAR; PG8_WAIT_L(0); PG8_MMA(0, 1, At, B1); PG8_BAR;
            PG8_LDA(At, 1, 1); PG8_STAGE(PG8_SA(1, 0), a3, voffA);
            PG8_BAR; PG8_WAIT_L(0); PG8_MMA(1, 0, At, B0); PG8_BAR; PG8_SCHED;
            PG8_STAGE(PG8_SB(1, 1), b3 + hstep, voffB);
            PG8_WAIT_V(6); PG8_BAR; PG8_MMA(1, 1, At, B1); PG8_BAR;
            }
        }
        if constexpr (ALIGN_EPI) { if (wr == 0) PG8_BAR; }
        if constexpr (!Epi::AFTER_DRAIN) { E(acc, cur, wr, wc, fr, fq); S.done(cur); }
        if (!has_next) break;
#pragma unroll
        for (int a = 0; a < 2; ++a)
#pragma unroll
            for (int b = 0; b < 2; ++b)
#pragma unroll
                for (int m = 0; m < 4; ++m)
#pragma unroll
                    for (int n = 0; n < 2; ++n) acc[a][b][m][n] = (f32x4){0.f, 0.f, 0.f, 0.f};
        cur = nxt; cA = nA; cB = nB; ++ui;
        if constexpr (ALIGN_EPI) { if (wr == 1) PG8_BAR; }
    }
    PG8_WAIT_V(0);
    if constexpr (!ALIGN_EPI) { if (wr == 0) PG8_BAR; }
    PG8_BAR;
    if constexpr (Epi::AFTER_DRAIN) { E.fused(acc, cur, wr, wc, fr, fq, lds, wid, lane); S.done(cur); }
#undef PG8_SA
#undef PG8_SB
#undef PG8_STAGE
#undef PG8_LDA
#undef PG8_LDB
#undef PG8_MMA
#undef PG8_WAIT_V
#undef PG8_WAIT_L
#undef PG8_BAR
#undef PG8_SCHED
}
}

constexpr int NWAVES = 8;
constexpr int DM = 4096, MP = 8192, NB = 8, DS = 64, MS = NB * DS, M = MP + MS, PAST = 2048, KS = PAST + DS  ;
constexpr int DFF = 11008, GW = 2048, NG = 16, NH = 16, KVR = 512, QR = 1024, INW = 5696, ZW = 3648, QW = 3072;
constexpr int LATROWS = MP + NB * KS;
constexpr int NMOD = 9 * DM;
constexpr float LN_EPS = 1e-5f, RMS_EPS = 1e-6f;
constexpr float QSCALE = 0.07216878364870322f * 1.4426950408889634f;
#ifndef MK_PER_PHASE
#define MK_PER_PHASE 1
#endif
constexpr int N_PHASES = 14;

constexpr size_t MiB = 1u << 20;
constexpr size_t WS_CTL = 0, CTL_ZERO_BYTES = 1 * MiB;
constexpr size_t WS_MOD = 1 * MiB, WS_ROPE = 3 * MiB;
constexpr size_t WS_WGU1 = 8 * MiB, WS_WD1 = WS_WGU1 + 172 * MiB, WS_WGU2 = WS_WD1 + 86 * MiB, WS_WD2 = WS_WGU2 + 172 * MiB;
constexpr size_t WS_WIN = WS_WD2 + 86 * MiB, WS_WUQ = WS_WIN + 46 * MiB, WS_WUK = WS_WUQ + 6 * MiB, WS_WUV = WS_WUK + 2 * MiB, WS_WOUT = WS_WUV + 2 * MiB;
constexpr size_t WS_H = WS_WOUT + 32 * MiB, WS_ACT = WS_H + 68 * MiB, WS_T = WS_ACT + 183 * MiB, WS_X = WS_T + 136 * MiB;
constexpr size_t WS_U = WS_X + 136 * MiB, WS_Z = WS_U + 34 * MiB, WS_VN = WS_Z + 122 * MiB, WS_CQN = WS_VN + 34 * MiB, WS_LAT = WS_CQN + 17 * MiB;
constexpr size_t WS_Q = WS_LAT + 25 * MiB, WS_KALL = WS_Q + 51 * MiB, WS_VTP = WS_KALL + 147 * MiB, WS_VTS = WS_VTP + 32 * MiB, WS_MIX = WS_VTS + 66 * MiB;
constexpr size_t WS_END = WS_MIX + 68 * MiB;
constexpr int CW_TMO = 0, CW_BAR = 4096;
constexpr size_t O_Y = 0, O_LATP = (size_t)M * DM, O_KRP = O_LATP + (size_t)MP * KVR, O_LATS = O_KRP + (size_t)MP * 64, O_KRS = O_LATS + (size_t)MS * KVR, O_VS = O_KRS + (size_t)MS * 64;

constexpr int RING_OFF = 0, RING_BYTES = 131072;
constexpr int LDSCTL_OFF = RING_BYTES, MISC_OFF = LDSCTL_OFF + 320;
constexpr int LDS_BYTES = 147456;

#define GAS __attribute__((address_space(1)))
#define LAS __attribute__((address_space(3)))
typedef unsigned short bf16;
typedef unsigned v4u __attribute__((ext_vector_type(4)));
typedef float f32x4 __attribute__((ext_vector_type(4)));
typedef short bf16x8 __attribute__((ext_vector_type(8)));
typedef GAS unsigned gu32;
typedef GAS unsigned long long gu64;
#define RLX_AGENT __ATOMIC_RELAXED, __HIP_MEMORY_SCOPE_AGENT
#define LDS_WAIT() asm volatile("s_waitcnt lgkmcnt(0)" ::: "memory")
#define VM_WAIT() asm volatile("s_waitcnt vmcnt(0)" ::: "memory")
__device__ __forceinline__ unsigned long long rt() { return __builtin_amdgcn_s_memrealtime(); }
__device__ __forceinline__ unsigned f2bf(float f) { unsigned u = __builtin_bit_cast(unsigned, f); return (u + 0x7fffu + ((u >> 16) & 1u)) >> 16; }
__device__ __forceinline__ unsigned pk2(float lo, float hi) { return f2bf(lo) | (f2bf(hi) << 16); }
#define XB_TMO      128
#define XB_XCNT(j)  (256  + 64 * (j))
#define XB_XSUB(j)  (1280 + 64 * (j))
#define XB_XGEN(j)  (2304 + 64 * (j))
#define XB_TOP      3328
#define XB_TOPGEN   3392
#define XCD_BAR_WORDS 3456
#define XB_SPIN_CAP (1u << 18)

__device__ __forceinline__ unsigned xb_ld(unsigned* p)              { return __hip_atomic_load(p, __ATOMIC_RELAXED, __HIP_MEMORY_SCOPE_AGENT); }
__device__ __forceinline__ unsigned xb_add(unsigned* p, unsigned v) { return __hip_atomic_fetch_add(p, v, __ATOMIC_RELAXED, __HIP_MEMORY_SCOPE_AGENT); }
__device__ __forceinline__ unsigned xb_xcc_id() { return (unsigned)__builtin_amdgcn_s_getreg((3 << 11) | 20) & 0xFu; }
#define XB_SPIN(cond, bar) do { unsigned _sp = 0; while (cond) { __builtin_amdgcn_s_sleep(1); \
    if ((++_sp & 255u) == 0u) { if (xb_ld(&(bar)[XB_TMO])) break; if (_sp > XB_SPIN_CAP) { atomicAdd(&(bar)[XB_TMO], 1u); break; } } } } while (0)

struct XcdBarrier {
    unsigned* bar; unsigned x;
    volatile LAS unsigned* st;
};

__device__ __forceinline__ XcdBarrier xcd_barrier_post(unsigned* bar, volatile LAS unsigned* st) {
    XcdBarrier b; b.bar = bar; b.x = xb_xcc_id(); b.st = st;
    if (threadIdx.x == 0) (void)xb_add(&bar[XB_XCNT(b.x)], 1u);
    return b;
}
__device__ __forceinline__ void xcd_barrier_complete(unsigned* bar, unsigned x, unsigned& nloc, unsigned& nx) {
    const unsigned G = gridDim.x * gridDim.y * gridDim.z;
    unsigned sum, cnt, mine, sp = 0u;
    for (;;) {
        sum = 0u; cnt = 0u; mine = 0u;
#pragma unroll
        for (unsigned j = 0; j < 16; ++j) { const unsigned c = xb_ld(&bar[XB_XCNT(j)]); sum += c; cnt += (c > 0u) ? 1u : 0u; mine = (j == x) ? c : mine; }
        if (sum == G) break;
        __builtin_amdgcn_s_sleep(1);
        if ((++sp & 255u) == 0u) { if (xb_ld(&bar[XB_TMO])) break; if (sp > XB_SPIN_CAP) { atomicAdd(&bar[XB_TMO], 1u); break; } }
    }
    nloc = mine > 0u ? mine : 1u; nx = cnt > 0u ? cnt : 1u;
}

__device__ __forceinline__ void xcd_barrier(const XcdBarrier& b) {
    asm volatile("s_waitcnt vmcnt(0)" ::: "memory");
    __syncthreads();
    if (threadIdx.x == 0) {
        unsigned* bar = b.bar;
        __builtin_amdgcn_s_waitcnt(0);
        unsigned nloc = b.st[0], nx = b.st[1];
        if (nloc == 0u) { xcd_barrier_complete(bar, b.x, nloc, nx); b.st[0] = nloc; b.st[1] = nx; }
        const unsigned old = xb_add(&bar[XB_XSUB(b.x)], 1u);
        const unsigned gen = old / nloc;
        if (old + 1u == (gen + 1u) * nloc) {
            __builtin_amdgcn_fence(__ATOMIC_RELEASE, "agent");
            asm volatile("s_waitcnt vmcnt(0)" ::: "memory");
            const unsigned og = xb_add(&bar[XB_TOP], 1u);
            const unsigned tg = og / nx;
            if (og + 1u == (tg + 1u) * nx) xb_add(&bar[XB_TOPGEN], 1u);
            else XB_SPIN(xb_ld(&bar[XB_TOPGEN]) == tg, bar);
            __builtin_amdgcn_fence(__ATOMIC_ACQUIRE, "agent");
            xb_add(&bar[XB_XGEN(b.x)], 1u);
            asm volatile("s_waitcnt vmcnt(0)" ::: "memory");
        } else {
            XB_SPIN(xb_ld(&bar[XB_XGEN(b.x)]) == gen, bar);
            __builtin_amdgcn_fence(__ATOMIC_ACQUIRE, "agent");
            asm volatile("s_waitcnt vmcnt(0)" ::: "memory");
        }
    }
    __syncthreads();
}


struct Frame {
    LAS unsigned char* lds;
    volatile LAS unsigned* MISC;
    gu32* ctl;
    int tid, lane, wave, vcu, G;
};
__device__ __forceinline__ float wave_sum(float v) {
#pragma unroll
    for (int o = 1; o < 64; o <<= 1) v += __shfl_xor(v, o);
    return v;
}
__device__ __forceinline__ int r_sidx(int r) { return r < MP ? 0 : 1 + ((r - MP) >> 6); }
__device__ __forceinline__ int r_pos(int r) { return r < MP ? r : PAST + ((r - MP) & 63); }
__device__ __forceinline__ int r_keyrow(int r) { return r < MP ? r : MP + ((r - MP) >> 6) * KS + PAST + ((r - MP) & 63); }

__device__ __forceinline__ void transpose_item(const float* W, int K, int N, bf16* WT, int k0, int n0, int row0, LAS float* scr, int lane) {
#pragma unroll 8
    for (int i = 0; i < 32; ++i) { const int kk = 2 * i + (lane >> 5); scr[kk * 33 + (lane & 31)] = W[(size_t)(k0 + kk) * N + n0 + (lane & 31)]; }
    LDS_WAIT(); asm volatile("" ::: "memory");
    const int c = lane & 7;
#pragma unroll
    for (int j = 0; j < 4; ++j) { const int n = (lane >> 3) + 8 * j; const LAS float* s = scr + (8 * c) * 33 + n;
        v4u o; o.x = pk2(s[0 * 33], s[1 * 33]); o.y = pk2(s[2 * 33], s[3 * 33]); o.z = pk2(s[4 * 33], s[5 * 33]); o.w = pk2(s[6 * 33], s[7 * 33]);
        *(GAS v4u*)(WT + (size_t)(row0 + n) * K + k0 + 8 * c) = o; }
    LDS_WAIT(); asm volatile("" ::: "memory");
}
__device__ __forceinline__ int map_gu(int n0) { const int up = n0 >= DFF, j = up ? n0 - DFF : n0; return 256 * (j >> 7) + (up ? 128 : 0) + (j & 127); }
__device__ __forceinline__ int map_uq(int n0) { const int head = n0 / 192, e = n0 - head * 192;
    if (e < 128) return head * 128 + e;
    return 2048 + 256 * (head >> 2) + (e >= 160 ? 128 : 0) + 32 * (head & 3) + (e & 31); }
__device__ __forceinline__ int map_ukv(int n0) { const int head = n0 >> 8, e = n0 & 255; return (e < 128 ? 0 : 2048) + head * 128 + (e & 127); }

template <int MAP> __device__ __forceinline__ void transpose_matrix(Frame& F, const float* W, int K, int N, bf16* WT, int& it0) {
    LAS float* scr = (LAS float*)(F.lds + RING_OFF + F.wave * 16384);
    const int gw = F.vcu * NWAVES + F.wave, NGW = F.G * NWAVES;
    const int nblk = N / 32, nitems = (K / 64) * nblk;
    int first = (gw - (it0 % NGW) + NGW) % NGW;
    for (int it = first; it < nitems; it += NGW) {
        const int kb = it / nblk, nb = it - kb * nblk, n0 = 32 * nb;
        const int row0 = MAP == 1 ? map_gu(n0) : MAP == 2 ? map_uq(n0) : MAP == 3 ? map_ukv(n0) : n0;
        transpose_item(W, K, N, WT, 64 * kb, n0, row0, scr, F.lane);
    }
    it0 += nitems;
}

__device__ __forceinline__ void mod_phase(Frame& F, const float* cp, const float* cs, const float* wada, const float* bada, float* mod) {
    LAS float* red = (LAS float*)(F.lds + RING_OFF);
    const int lane = F.lane, w = F.wave;
    for (int cb = F.vcu; cb < NMOD / 144; cb += F.G) {
        const int lc = lane < 36 ? lane : 35;
        const float* wp = wada + (size_t)(512 * w) * NMOD + cb * 144 + 4 * lc;
        f32x4 acc[9];
#pragma unroll
        for (int b = 0; b < 9; ++b) acc[b] = (f32x4){0.f, 0.f, 0.f, 0.f};
        for (int kb = 0; kb < 8; ++kb) {
            float sv[9];
            { const int k = 512 * w + 64 * kb + lane;
#pragma unroll
              for (int b = 0; b < 9; ++b) { const float c = b == 0 ? cp[k] : cs[(b - 1) * DM + k]; sv[b] = c * __builtin_amdgcn_rcpf(1.0f + __builtin_amdgcn_exp2f(-1.4426950408889634f * c)); } }
#pragma unroll 8
            for (int kk = 0; kk < 64; ++kk) {
                const f32x4 wv = *(const f32x4*)(wp + (size_t)(64 * kb + kk) * NMOD);
#pragma unroll
                for (int b = 0; b < 9; ++b) { const float s = __builtin_bit_cast(float, __builtin_amdgcn_readlane(__builtin_bit_cast(int, sv[b]), kk)); acc[b] += wv * s; }
            }
        }
        if (lane < 36) {
#pragma unroll
            for (int b = 0; b < 9; ++b) *(LAS f32x4*)(red + (w * 9 + b) * 144 + 4 * lane) = acc[b];
        }
        LDS_WAIT(); __syncthreads();
        for (int o = F.tid; o < 9 * 144; o += NWAVES * 64) { const int b = o / 144, c = o - b * 144; float s = bada[cb * 144 + c];
#pragma unroll
            for (int ww = 0; ww < 8; ++ww) s += red[(ww * 9 + b) * 144 + c];
            mod[(size_t)b * NMOD + cb * 144 + c] = s; }
        __syncthreads();
    }
}
__device__ __forceinline__ void rope_phase(Frame& F, float* rope) {
    const int gt = F.vcu * (NWAVES * 64) + F.tid, NT = F.G * NWAVES * 64;
    for (int idx = gt; idx < MP * 32; idx += NT) {
        const int pos = idx >> 5, i = idx & 31;
        const double inv = exp2(-(double)i * (13.287712379549449 / 32.0));
        const double ang = (double)pos * inv;
        const double n = rint(ang * 0.15915494309189535);
        double r = fma(-n, 6.283185307179586, ang); r = fma(-n, 2.4492935982947064e-16, r);
        const float rf = (float)r;
        rope[(size_t)pos * 64 + i] = cosf(rf); rope[(size_t)pos * 64 + 32 + i] = sinf(rf);
    }
}
__device__ __forceinline__ void krope_store16(bf16* krow  , float v, int lane) {
    const unsigned mine = f2bf(v);
    unsigned e[8];
#pragma unroll
    for (int j = 0; j < 8; ++j) e[j] = (unsigned)__shfl((int)mine, 8 * (lane & 7) + j);
    v4u o; o.x = e[0] | (e[1] << 16); o.y = e[2] | (e[3] << 16); o.z = e[4] | (e[5] << 16); o.w = e[6] | (e[7] << 16);
    const int hg = lane >> 3, ch = lane & 7;
    *(GAS v4u*)(krow + hg * 192 + 128 + 8 * ch) = o;
    *(GAS v4u*)(krow + (hg + 8) * 192 + 128 + 8 * ch) = o;
}
__device__ __forceinline__ void cache_phase(Frame& F, const float* clat, const float* ckr, bf16* LAT, bf16* KALL) {
    const int gw = F.vcu * NWAVES + F.wave, NGW = F.G * NWAVES, lane = F.lane;
    for (int rr = gw; rr < NB * PAST; rr += NGW) {
        const int b = rr / PAST, j = rr - b * PAST; const size_t krow = (size_t)MP + (size_t)b * KS + j;
        const f32x4 a = *(const f32x4*)(clat + (size_t)rr * KVR + 8 * lane), c = *(const f32x4*)(clat + (size_t)rr * KVR + 8 * lane + 4);
        v4u o; o.x = pk2(a[0], a[1]); o.y = pk2(a[2], a[3]); o.z = pk2(c[0], c[1]); o.w = pk2(c[2], c[3]);
        *(GAS v4u*)(LAT + krow * KVR + 8 * lane) = o;
        krope_store16(KALL + krow * QW, ckr[(size_t)rr * 64 + lane], lane);
    }
}
__device__ __forceinline__ void modulate_rows(Frame& F, const float* xp, const float* xs, const float* mod, int ksh, bf16* H) {
    const int gw = F.vcu * NWAVES + F.wave, NGW = F.G * NWAVES, lane = F.lane;
    for (int r = gw; r < M; r += NGW) {
        const float* x = r < MP ? xp + (size_t)r * DM : xs + (size_t)(r - MP) * DM;
        const float* sh = mod + (size_t)r_sidx(r) * NMOD + ksh * DM; const float* sc = sh + DM;
#pragma unroll 4
        for (int j = 0; j < 16; ++j) { const int c = 4 * lane + 256 * j;
            const f32x4 xv = *(const f32x4*)(x + c), a = *(const f32x4*)(sh + c), s = *(const f32x4*)(sc + c);
            const f32x4 h = xv * (s + 1.0f) + a;
            unsigned long long o = (unsigned long long)pk2(h[0], h[1]) | ((unsigned long long)pk2(h[2], h[3]) << 32);
            *(GAS unsigned long long*)(H + (size_t)r * DM + c) = o; }
    }
}
template <bool HAS_H> __device__ __forceinline__ void ln_rows(Frame& F, const float* T, const float* g, const float* b, float* Xout, const float* mod, int ksh, bf16* H) {
    const int gw = F.vcu * NWAVES + F.wave, NGW = F.G * NWAVES, lane = F.lane;
    for (int r = gw; r < M; r += NGW) {
        const float* t = T + (size_t)r * DM;
        f32x4 v[16]; float s = 0.f;
#pragma unroll
        for (int j = 0; j < 16; ++j) { v[j] = *(const f32x4*)(t + 4 * lane + 256 * j); s += (v[j][0] + v[j][1]) + (v[j][2] + v[j][3]); }
        const float mean = wave_sum(s) * (1.f / DM); float q = 0.f;
#pragma unroll
        for (int j = 0; j < 16; ++j) { v[j] = v[j] - mean; q += (v[j][0] * v[j][0] + v[j][1] * v[j][1]) + (v[j][2] * v[j][2] + v[j][3] * v[j][3]); }
        const float rstd = 1.0f / sqrtf(wave_sum(q) * (1.f / DM) + LN_EPS);
        const float* sh = mod + (size_t)r_sidx(r) * NMOD + ksh * DM; const float* sc = sh + DM;
#pragma unroll
        for (int j = 0; j < 16; ++j) { const int c = 4 * lane + 256 * j;
            const f32x4 y = v[j] * rstd * *(const f32x4*)(g + c) + *(const f32x4*)(b + c);
            *(f32x4*)(Xout + (size_t)r * DM + c) = y;
            if (HAS_H) { const f32x4 h = y * (*(const f32x4*)(sc + c) + 1.0f) + *(const f32x4*)(sh + c);
                unsigned long long o = (unsigned long long)pk2(h[0], h[1]) | ((unsigned long long)pk2(h[2], h[3]) << 32);
                *(GAS unsigned long long*)(H + (size_t)r * DM + c) = o; } }
    }
}
__device__ __forceinline__ void mixer_rows(Frame& F, const float* Z, const float* lng, const float* lnb, const float* qg, const float* kvg, const float* rope,
                                           bf16* VN, bf16* CQN, bf16* LAT, bf16* KALL, float* out) {
    const int gw = F.vcu * NWAVES + F.wave, NGW = F.G * NWAVES, lane = F.lane;
    for (int r = gw; r < M; r += NGW) {
        const float* z = Z + (size_t)r * ZW;
        const bool smp = r >= MP; const int rs = r - MP;
        {
            f32x4 v[8]; float s = 0.f;
#pragma unroll
            for (int j = 0; j < 8; ++j) { v[j] = *(const f32x4*)(z + 4 * lane + 256 * j); s += (v[j][0] + v[j][1]) + (v[j][2] + v[j][3]); }
            const float mean = wave_sum(s) * (1.f / GW); float q = 0.f;
#pragma unroll
            for (int j = 0; j < 8; ++j) { v[j] = v[j] - mean; q += (v[j][0] * v[j][0] + v[j][1] * v[j][1]) + (v[j][2] * v[j][2] + v[j][3] * v[j][3]); }
            const float rstd = 1.0f / sqrtf(wave_sum(q) * (1.f / GW) + LN_EPS);
#pragma unroll
            for (int j = 0; j < 8; ++j) { const int c = 4 * lane + 256 * j;
                const f32x4 y = v[j] * rstd * *(const f32x4*)(lng + c) + *(const f32x4*)(lnb + c);
                unsigned long long o = (unsigned long long)pk2(y[0], y[1]) | ((unsigned long long)pk2(y[2], y[3]) << 32);
                *(GAS unsigned long long*)(VN + (size_t)r * GW + c) = o;
                if (smp) *(f32x4*)(out + O_VS + (size_t)rs * GW + c) = y; }
        }
        {
            f32x4 v[4]; float q = 0.f;
#pragma unroll
            for (int j = 0; j < 4; ++j) { v[j] = *(const f32x4*)(z + 2048 + 4 * lane + 256 * j); q += (v[j][0] * v[j][0] + v[j][1] * v[j][1]) + (v[j][2] * v[j][2] + v[j][3] * v[j][3]); }
            const float rs_ = 1.0f / sqrtf(wave_sum(q) * (1.f / QR) + RMS_EPS);
#pragma unroll
            for (int j = 0; j < 4; ++j) { const int c = 4 * lane + 256 * j; const f32x4 y = v[j] * rs_ * *(const f32x4*)(qg + c);
                unsigned long long o = (unsigned long long)pk2(y[0], y[1]) | ((unsigned long long)pk2(y[2], y[3]) << 32);
                *(GAS unsigned long long*)(CQN + (size_t)r * QR + c) = o; }
        }
        const size_t krow = (size_t)r_keyrow(r);
        {
            f32x4 v[2]; float q = 0.f;
#pragma unroll
            for (int j = 0; j < 2; ++j) { v[j] = *(const f32x4*)(z + 3072 + 4 * lane + 256 * j); q += (v[j][0] * v[j][0] + v[j][1] * v[j][1]) + (v[j][2] * v[j][2] + v[j][3] * v[j][3]); }
            const float rs_ = 1.0f / sqrtf(wave_sum(q) * (1.f / KVR) + RMS_EPS);
            float* lo = smp ? out + O_LATS + (size_t)rs * KVR : out + O_LATP + (size_t)r * KVR;
#pragma unroll
            for (int j = 0; j < 2; ++j) { const int c = 4 * lane + 256 * j; const f32x4 y = v[j] * rs_ * *(const f32x4*)(kvg + c);
                *(f32x4*)(lo + c) = y;
                unsigned long long o = (unsigned long long)pk2(y[0], y[1]) | ((unsigned long long)pk2(y[2], y[3]) << 32);
                *(GAS unsigned long long*)(LAT + krow * KVR + c) = o; }
        }
        {
            const float x = z[3584 + lane], xo = __shfl_xor(x, 32);
            const int i = lane & 31; const float c = rope[(size_t)r_pos(r) * 64 + i], s = rope[(size_t)r_pos(r) * 64 + 32 + i];
            const float y = lane < 32 ? x * c - xo * s : x * c + xo * s;
            float* ko = smp ? out + O_KRS + (size_t)rs * 64 : out + O_KRP + (size_t)r * 64;
            ko[lane] = y;
            krope_store16(KALL + krow * QW, y, lane);
        }
    }
}

typedef float f32x16 __attribute__((ext_vector_type(16)));
__device__ __forceinline__ int crow(int r, int hi) { return (r & 3) + 8 * (r >> 2) + 4 * hi; }
constexpr int GT_STRIDE = 272;
__device__ __forceinline__ void gate_unit(Frame& F, int r0, int L, int g, const bf16* VN, const bf16* U, const float* ws, const float* bs, bf16* MIX) {
    LAS unsigned char* vT = F.lds + RING_OFF;
    const int tid = F.tid, lane = F.lane, w = F.wave, r32 = lane & 31, hi = lane >> 5;
    for (int id = tid; id < L * 16; id += NWAVES * 64) { const int s = id >> 4, cc = id & 15;
        const v4u d = *(const GAS v4u*)(VN + (size_t)(r0 + s) * GW + g * 128 + cc * 8);
        LAS unsigned short* dst = (LAS unsigned short*)(vT + (cc * 8) * GT_STRIDE + s * 2);
        dst[0 * (GT_STRIDE / 2)] = (unsigned short)(d.x & 0xffff); dst[1 * (GT_STRIDE / 2)] = (unsigned short)(d.x >> 16);
        dst[2 * (GT_STRIDE / 2)] = (unsigned short)(d.y & 0xffff); dst[3 * (GT_STRIDE / 2)] = (unsigned short)(d.y >> 16);
        dst[4 * (GT_STRIDE / 2)] = (unsigned short)(d.z & 0xffff); dst[5 * (GT_STRIDE / 2)] = (unsigned short)(d.z >> 16);
        dst[6 * (GT_STRIDE / 2)] = (unsigned short)(d.w & 0xffff); dst[7 * (GT_STRIDE / 2)] = (unsigned short)(d.w >> 16); }
    LDS_WAIT(); __syncthreads();
    const int mt = w >> 1;
    if (32 * mt < L) {
        f32x16 acc[2]; acc[0] = f32x16{}; acc[1] = f32x16{};
        const int t = 32 * mt + r32;
        const float* wrow = ws + (size_t)g * 128 * 128 + (size_t)t * 128;
        for (int ks = 0; ks < 2 * mt + 2; ++ks) {
            const int s0 = 16 * ks + 8 * hi;
            const f32x4 a = *(const f32x4*)(wrow + s0), c = *(const f32x4*)(wrow + s0 + 4);
            float e[8] = {a[0], a[1], a[2], a[3], c[0], c[1], c[2], c[3]};
#pragma unroll
            for (int j = 0; j < 8; ++j) if (s0 + j > t) e[j] = 0.f;
            v4u aw; aw.x = pk2(e[0], e[1]); aw.y = pk2(e[2], e[3]); aw.z = pk2(e[4], e[5]); aw.w = pk2(e[6], e[7]);
            const bf16x8 af = __builtin_bit_cast(bf16x8, aw);
#pragma unroll
            for (int nn = 0; nn < 2; ++nn) {
                const int c0 = 32 * (2 * (w & 1) + nn) + r32;
                const bf16x8 bfr = *(const LAS bf16x8*)(vT + c0 * GT_STRIDE + s0 * 2);
                acc[nn] = __builtin_amdgcn_mfma_f32_32x32x16_bf16(af, bfr, acc[nn], 0, 0, 0);
            }
        }
#pragma unroll
        for (int nn = 0; nn < 2; ++nn) {
            const int c = g * 128 + 32 * (2 * (w & 1) + nn) + r32;
#pragma unroll
            for (int r = 0; r < 16; ++r) { const int tt = 32 * mt + crow(r, hi);
                const float uval = __builtin_bit_cast(float, (unsigned)U[(size_t)(r0 + tt) * GW + c] << 16);
                const float val = uval * (acc[nn][r] + bs[g * 128 + tt]);
                MIX[(size_t)(r0 + tt) * DM + c] = (bf16)f2bf(val); }
        }
    }
    __syncthreads();
}

constexpr int AK_STRIDE = 400, AV_STRIDE = 144, AK_BYTES = 64 * AK_STRIDE, AV_BYTES = 128 * AV_STRIDE, ABUF = AK_BYTES + AV_BYTES;
constexpr float ATT_THR = 8.0f;
__device__ __forceinline__ void attn_unit(Frame& F, const bf16* Qb, const bf16* Kb, const bf16* Vt, int vstride, bf16* Ob, int T_max, int my_nt) {
    const int tid = F.tid, lane = F.lane, w = F.wave, r32 = lane & 31, hi = lane >> 5;
    LAS unsigned char* base = F.lds + RING_OFF;
    int kg[3], kl[3], vg[2], vl[2];
#pragma unroll
    for (int i = 0; i < 3; ++i) { const int id = tid + 512 * i, kr = id / 24, ch = id - kr * 24; kg[i] = kr * QW + ch * 8; kl[i] = kr * AK_STRIDE + ch * 16; }
#pragma unroll
    for (int i = 0; i < 2; ++i) { const int id = tid + 512 * i, d = id >> 3, ch = id & 7; vg[i] = d * vstride + ch * 8; vl[i] = AK_BYTES + d * AV_STRIDE + ch * 16; }
    v4u kreg[3], vreg[2];
#define A_LOAD(t) do { _Pragma("unroll") for (int i_ = 0; i_ < 3; ++i_) kreg[i_] = *(const GAS v4u*)(Kb + (size_t)(t) * 64 * QW + kg[i_]); \
                       _Pragma("unroll") for (int i_ = 0; i_ < 2; ++i_) vreg[i_] = *(const GAS v4u*)(Vt + (size_t)(t) * 64 + vg[i_]); } while (0)
#define A_WRITE(buf) do { _Pragma("unroll") for (int i_ = 0; i_ < 3; ++i_) *(LAS v4u*)(base + (buf) * ABUF + kl[i_]) = kreg[i_]; \
                          _Pragma("unroll") for (int i_ = 0; i_ < 2; ++i_) *(LAS v4u*)(base + (buf) * ABUF + vl[i_]) = vreg[i_]; } while (0)
    A_LOAD(0);
    bf16x8 qf[12];
    if (my_nt > 0) {
#pragma unroll
        for (int d0 = 0; d0 < 12; ++d0) qf[d0] = *(const GAS bf16x8*)(Qb + (size_t)(32 * w + r32) * QW + 16 * d0 + 8 * hi);
    } else {
#pragma unroll
        for (int d0 = 0; d0 < 12; ++d0) qf[d0] = bf16x8{};
    }
    A_WRITE(0);
    LDS_WAIT(); __syncthreads();
    f32x16 o[4]; o[0] = f32x16{}; o[1] = f32x16{}; o[2] = f32x16{}; o[3] = f32x16{};
    float m = -1e30f, lsum = 0.f;
    const int koff = r32 * AK_STRIDE + hi * 16, voff = AK_BYTES + r32 * AV_STRIDE + hi * 16;
    for (int t = 0; t < T_max; ++t) {
        const bool more = t + 1 < T_max;
        if (more) A_LOAD(t + 1);
        if (t < my_nt) {
            LAS unsigned char* kb = base + (t & 1) * ABUF + koff; LAS unsigned char* vb = base + (t & 1) * ABUF + voff;
            f32x16 p0 = f32x16{}, p1 = f32x16{};
#pragma unroll
            for (int d0 = 0; d0 < 12; ++d0) {
                const bf16x8 k0 = *(const LAS bf16x8*)(kb + d0 * 32), k1 = *(const LAS bf16x8*)(kb + 32 * AK_STRIDE + d0 * 32);
                p0 = __builtin_amdgcn_mfma_f32_32x32x16_bf16(k0, qf[d0], p0, 0, 0, 0);
                p1 = __builtin_amdgcn_mfma_f32_32x32x16_bf16(k1, qf[d0], p1, 0, 0, 0);
            }
            float mx = p0[0];
#pragma unroll
            for (int r = 1; r < 16; ++r) mx = fmaxf(mx, p0[r]);
#pragma unroll
            for (int r = 0; r < 16; ++r) mx = fmaxf(mx, p1[r]);
            mx = fmaxf(mx, __shfl_xor(mx, 32));
            if (!__all(mx - m <= ATT_THR)) {
                const float mn = fmaxf(m, mx), al = __builtin_amdgcn_exp2f(m - mn); m = mn; lsum *= al;
#pragma unroll
                for (int d0 = 0; d0 < 4; ++d0) o[d0] = o[d0] * al;
            }
            float ps = 0.f;
#pragma unroll
            for (int r = 0; r < 16; ++r) { p0[r] = __builtin_amdgcn_exp2f(p0[r] - m); p1[r] = __builtin_amdgcn_exp2f(p1[r] - m); ps += p0[r] + p1[r]; }
            lsum += ps;
            bf16x8 pf[4];
            { v4u x;
              x.x = pg8::cvt_pk_bf16(p0[0], p0[1]); x.y = pg8::cvt_pk_bf16(p0[2], p0[3]); x.z = pg8::cvt_pk_bf16(p0[4], p0[5]); x.w = pg8::cvt_pk_bf16(p0[6], p0[7]); pf[0] = __builtin_bit_cast(bf16x8, x);
              x.x = pg8::cvt_pk_bf16(p0[8], p0[9]); x.y = pg8::cvt_pk_bf16(p0[10], p0[11]); x.z = pg8::cvt_pk_bf16(p0[12], p0[13]); x.w = pg8::cvt_pk_bf16(p0[14], p0[15]); pf[1] = __builtin_bit_cast(bf16x8, x);
              x.x = pg8::cvt_pk_bf16(p1[0], p1[1]); x.y = pg8::cvt_pk_bf16(p1[2], p1[3]); x.z = pg8::cvt_pk_bf16(p1[4], p1[5]); x.w = pg8::cvt_pk_bf16(p1[6], p1[7]); pf[2] = __builtin_bit_cast(bf16x8, x);
              x.x = pg8::cvt_pk_bf16(p1[8], p1[9]); x.y = pg8::cvt_pk_bf16(p1[10], p1[11]); x.z = pg8::cvt_pk_bf16(p1[12], p1[13]); x.w = pg8::cvt_pk_bf16(p1[14], p1[15]); pf[3] = __builtin_bit_cast(bf16x8, x); }
#pragma unroll
            for (int d0 = 0; d0 < 4; ++d0)
#pragma unroll
                for (int s = 0; s < 4; ++s) {
                    const bf16x8 vf = *(const LAS bf16x8*)(vb + d0 * 32 * AV_STRIDE + s * 32);
                    o[d0] = __builtin_amdgcn_mfma_f32_32x32x16_bf16(vf, pf[s], o[d0], 0, 0, 0);
                }
        }
        if (more) A_WRITE((t + 1) & 1);
        LDS_WAIT(); __syncthreads();
    }
    if (my_nt > 0) {
        const float lt = lsum + __shfl_xor(lsum, 32), inv = 1.0f / lt;
        bf16* orow = Ob + (size_t)(32 * w + r32) * DM + 4 * hi;
#pragma unroll
        for (int d0 = 0; d0 < 4; ++d0)
#pragma unroll
            for (int g4 = 0; g4 < 4; ++g4) {
                pg8::u32x2 wv; wv.x = pg8::cvt_pk_bf16(o[d0][4 * g4] * inv, o[d0][4 * g4 + 1] * inv); wv.y = pg8::cvt_pk_bf16(o[d0][4 * g4 + 2] * inv, o[d0][4 * g4 + 3] * inv);
                *(GAS pg8::u32x2*)(orow + 32 * d0 + 8 * g4) = wv;
            }
    }
#undef A_LOAD
#undef A_WRITE
}

struct Args { const float* in[28]; float* out; unsigned char* ws; int ph_lo, ph_hi; };
__global__ void __launch_bounds__(NWAVES * 64, 2) mega_fwd(Args args) {
    extern __shared__ __attribute__((aligned(16))) unsigned char lds[];
    Frame F;
    F.lds = (LAS unsigned char*)lds;
    F.MISC = (volatile LAS unsigned*)(F.lds + MISC_OFF);
    F.tid = threadIdx.x; F.lane = F.tid & 63; F.wave = __builtin_amdgcn_readfirstlane(F.tid >> 6);
    F.G = gridDim.x; { const int bx = blockIdx.x; F.vcu = (F.G % 8 == 0) ? (bx % 8) * (F.G / 8) + bx / 8 : bx; }
    unsigned char* ws = args.ws;
    F.ctl = (gu32*)(ws + WS_CTL);
    for (int u = F.tid; u < (LDS_BYTES - LDSCTL_OFF) / 4; u += NWAVES * 64) ((LAS unsigned*)(F.lds + LDSCTL_OFF))[u] = 0u;
    __syncthreads();
    XcdBarrier bar; bar.bar = (unsigned*)(F.ctl + CW_BAR); bar.x = 0; bar.st = nullptr;
    if (!MK_PER_PHASE) bar = xcd_barrier_post((unsigned*)(F.ctl + CW_BAR), F.MISC + 8);
#define GRID_BAR() do { if (!MK_PER_PHASE) xcd_barrier(bar); } while (0)
    const int lo = args.ph_lo, hi = args.ph_hi;
#define IN(k) (lo <= (k) && (k) < hi)
#define BOTH(k) (IN(k) && IN((k) + 1))

    const float* x_p = args.in[0]; const float* x_s = args.in[1];
    float* mod = (float*)(ws + WS_MOD); float* rope = (float*)(ws + WS_ROPE);
    bf16* WGU1 = (bf16*)(ws + WS_WGU1); bf16* WD1 = (bf16*)(ws + WS_WD1); bf16* WGU2 = (bf16*)(ws + WS_WGU2); bf16* WD2 = (bf16*)(ws + WS_WD2);
    bf16* WIN = (bf16*)(ws + WS_WIN); bf16* WUQ = (bf16*)(ws + WS_WUQ); bf16* WUK = (bf16*)(ws + WS_WUK); bf16* WUV = (bf16*)(ws + WS_WUV); bf16* WOUT = (bf16*)(ws + WS_WOUT);
    bf16* H = (bf16*)(ws + WS_H); bf16* ACT = (bf16*)(ws + WS_ACT); float* T = (float*)(ws + WS_T); float* X = (float*)(ws + WS_X);
    bf16* U = (bf16*)(ws + WS_U); float* Z = (float*)(ws + WS_Z); bf16* VN = (bf16*)(ws + WS_VN); bf16* CQN = (bf16*)(ws + WS_CQN); bf16* LAT = (bf16*)(ws + WS_LAT);
    bf16* Q = (bf16*)(ws + WS_Q); bf16* KALL = (bf16*)(ws + WS_KALL); bf16* VTP = (bf16*)(ws + WS_VTP); bf16* VTS = (bf16*)(ws + WS_VTS); bf16* MIX = (bf16*)(ws + WS_MIX);

    if (IN(0)) {
        mod_phase(F, args.in[4], args.in[5], args.in[6], args.in[7], mod);
        rope_phase(F, rope);
        cache_phase(F, args.in[2], args.in[3], LAT, KALL);
        int it0 = 0;
        transpose_matrix<1>(F, args.in[8], DM, 2 * DFF, WGU1, it0);
        transpose_matrix<0>(F, args.in[9], DFF, DM, WD1, it0);
        transpose_matrix<0>(F, args.in[12], DM, INW, WIN, it0);
        transpose_matrix<2>(F, args.in[18], QR, QW, WUQ, it0);
        transpose_matrix<3>(F, args.in[20], KVR, 4096, WUK, it0);
        transpose_matrix<0>(F, args.in[21], DM, DM, WOUT, it0);
        transpose_matrix<1>(F, args.in[24], DM, 2 * DFF, WGU2, it0);
        transpose_matrix<0>(F, args.in[25], DFF, DM, WD2, it0);
        if (BOTH(0)) GRID_BAR();
    }
    if (IN(1)) { modulate_rows(F, x_p, x_s, mod, 0, H); if (BOTH(1)) GRID_BAR(); }
    if (IN(2)) {
        pg8::Gemm g{H, WGU1, M, 2 * DFF, DM}; pg8::StaticOrder S; S.init(M, 2 * DFF, F.G, (int)blockIdx.x);
        pg8::EpiSwiglu E{ACT, DFF};
        pg8::gemm_phase<pg8::EpiSwiglu, pg8::StaticOrder, true, true>(F.lds + RING_OFF, g, S, E);
        if (BOTH(2)) GRID_BAR();
    }
    if (IN(3)) {
        pg8::Gemm g{ACT, WD1, M, DM, DFF}; pg8::StaticOrder S; S.init(M, DM, F.G, (int)blockIdx.x);
        pg8::EpiResid E{x_p, x_s, mod + 2 * DM, T, 0.5f};
        pg8::gemm_phase<pg8::EpiResid, pg8::StaticOrder, true, true>(F.lds + RING_OFF, g, S, E);
        if (BOTH(3)) GRID_BAR();
    }
    if (IN(4)) { ln_rows<true>(F, T, args.in[10], args.in[11], X, mod, 3, H); if (BOTH(4)) GRID_BAR(); }
    if (IN(5)) {
        pg8::Gemm g{H, WIN, M, 5888, DM}; pg8::StaticOrder S; S.init(M, 5888, F.G, (int)blockIdx.x);
        pg8::EpiWin E{U, Z};
        pg8::gemm_phase<pg8::EpiWin, pg8::StaticOrder, true, true>(F.lds + RING_OFF, g, S, E);
        if (BOTH(5)) GRID_BAR();
    }
    if (IN(6)) { mixer_rows(F, Z, args.in[13], args.in[14], args.in[17], args.in[19], rope, VN, CQN, LAT, KALL, args.out); if (BOTH(6)) GRID_BAR(); }
    if (IN(7)) {
        { pg8::Gemm g{CQN, WUQ, M, QW, QR}; pg8::StaticOrder S; S.init(M, QW, F.G, (int)blockIdx.x);
          pg8::EpiHeads E{Q, QSCALE, 8, rope};
          pg8::gemm_phase<pg8::EpiHeads, pg8::StaticOrder, true, true>(F.lds + RING_OFF, g, S, E); }
        { pg8::Gemm g{LAT, WUK, LATROWS, 2048, KVR}; pg8::StaticOrder S; S.init(LATROWS, 2048, F.G, (int)blockIdx.x);
          pg8::EpiHeads E{KALL, 1.0f, 8, rope};
          pg8::gemm_phase<pg8::EpiHeads, pg8::StaticOrder, true, true>(F.lds + RING_OFF, g, S, E); }
        { pg8::Gemm g{WUV, LAT, 2048, LATROWS, KVR}; pg8::StaticOrder S; S.init(2048, LATROWS, F.G, (int)blockIdx.x);
          pg8::EpiVt E{VTP, VTS};
          pg8::gemm_phase<pg8::EpiVt, pg8::StaticOrder, true, true>(F.lds + RING_OFF, g, S, E); }
        if (BOTH(7)) GRID_BAR();
    }
    if (IN(8)) {
        for (int u = F.vcu; u < 512; u += F.G) {
            const int u2 = u & 255, h = u2 & 15, q2 = u2 >> 4, qb = (u >= 256) ? 31 - q2 : q2;
            attn_unit(F, Q + (size_t)(256 * qb) * QW + h * 192, KALL + h * 192, VTP + (size_t)(h * 128) * MP, MP, MIX + (size_t)(256 * qb) * DM + 2048 + h * 128,
                      4 * qb + 4, 4 * qb + (F.wave >> 1) + 1);
        }
        for (int u = F.G - 1 - F.vcu; u < 128; u += F.G) {
            const int b = u >> 4, h = u & 15;
            attn_unit(F, Q + (size_t)(MP + 64 * b) * QW + h * 192, KALL + (size_t)(MP + b * KS) * QW + h * 192, VTS + ((size_t)b * 2048 + h * 128) * KS, KS,
                      MIX + (size_t)(MP + 64 * b) * DM + 2048 + h * 128, 33, F.wave < 2 ? 33 : 0);
        }
        for (int u = F.vcu; u < 1024 + 128; u += F.G) {
            if (u < 1024) gate_unit(F, 128 * (u >> 4), 128, u & 15, VN, U, args.in[15], args.in[16], MIX);
            else { const int v = u - 1024; gate_unit(F, MP + 64 * (v >> 4), 64, v & 15, VN, U, args.in[15], args.in[16], MIX); }
        }
        if (BOTH(8)) GRID_BAR();
    }
    if (IN(9)) {
        pg8::Gemm g{MIX, WOUT, M, DM, DM}; pg8::StaticOrder S; S.init(M, DM, F.G, (int)blockIdx.x);
        pg8::EpiResid E{X, X + (size_t)MP * DM, mod + 5 * DM, T, 1.0f};
        pg8::gemm_phase<pg8::EpiResid, pg8::StaticOrder, true, true>(F.lds + RING_OFF, g, S, E);
        if (BOTH(9)) GRID_BAR();
    }
    if (IN(10)) { ln_rows<true>(F, T, args.in[22], args.in[23], X, mod, 6, H); if (BOTH(10)) GRID_BAR(); }
    if (IN(11)) {
        pg8::Gemm g{H, WGU2, M, 2 * DFF, DM}; pg8::StaticOrder S; S.init(M, 2 * DFF, F.G, (int)blockIdx.x);
        pg8::EpiSwiglu E{ACT, DFF};
        pg8::gemm_phase<pg8::EpiSwiglu, pg8::StaticOrder, true, true>(F.lds + RING_OFF, g, S, E);
        if (BOTH(11)) GRID_BAR();
    }
    if (IN(12)) {
        pg8::Gemm g{ACT, WD2, M, DM, DFF}; pg8::StaticOrder S; S.init(M, DM, F.G, (int)blockIdx.x);
        pg8::EpiResid E{X, X + (size_t)MP * DM, mod + 8 * DM, T, 0.5f};
        pg8::gemm_phase<pg8::EpiResid, pg8::StaticOrder, true, true>(F.lds + RING_OFF, g, S, E);
        if (BOTH(12)) GRID_BAR();
    }
    if (IN(13)) { ln_rows<false>(F, T, args.in[26], args.in[27], args.out + O_Y, mod, 0, H); }
#undef IN
#undef BOTH
}

extern "C" void kernel_launch(void* const* d_in, const int* in_sizes, int n_in, void* d_out, int out_size, void* d_ws, size_t ws_size, hipStream_t stream) {
    static int grid = 0;
    if (grid == 0) {
        if (n_in != 28 || ws_size < WS_END) { fprintf(stderr, "kernel_launch: expected 28 inputs and >= %zu bytes of workspace; got %d, %zu\n", (size_t)WS_END, n_in, ws_size); grid = -1; return; }
        int dev = 0, cus = 0, per_cu = 0;
        if (hipGetDevice(&dev) != hipSuccess || hipDeviceGetAttribute(&cus, hipDeviceAttributeMultiprocessorCount, dev) != hipSuccess) { grid = -1; return; }
        if (hipFuncSetAttribute((const void*)mega_fwd, hipFuncAttributeMaxDynamicSharedMemorySize, LDS_BYTES) != hipSuccess) { fprintf(stderr, "kernel_launch: hipFuncSetAttribute failed\n"); grid = -1; return; }
        if (hipOccupancyMaxActiveBlocksPerMultiprocessor(&per_cu, (const void*)mega_fwd, NWAVES * 64, LDS_BYTES) != hipSuccess || per_cu < 1)
            fprintf(stderr, "kernel_launch: occupancy query reports %d blocks per CU\n", per_cu);
        (void)hipGetLastError();
        grid = cus;
    }
    if (grid < 0) return;
    if (hipMemsetAsync((char*)d_ws + WS_CTL, 0, CTL_ZERO_BYTES, stream) != hipSuccess) return;
    Args a{};
    for (int i = 0; i < 28; ++i) a.in[i] = (const float*)d_in[i];
    a.out = (float*)d_out; a.ws = (unsigned char*)d_ws;
#if MK_PER_PHASE
    for (int p = 0; p < N_PHASES; ++p) { a.ph_lo = p; a.ph_hi = p + 1; hipLaunchKernelGGL(mega_fwd, dim3(grid), dim3(NWAVES * 64), LDS_BYTES, stream, a); }
#else
    a.ph_lo = 0; a.ph_hi = N_PHASES; hipLaunchKernelGGL(mega_fwd, dim3(grid), dim3(NWAVES * 64), LDS_BYTES, stream, a);
#endif
    const hipError_t le = hipPeekAtLastError();
    if (le != hipSuccess) fprintf(stderr, "kernel_launch: launch failed: %s\n", hipGetErrorName(le));
}
```

```cpp
#include <hip/hip_runtime.h>
#include <cstdio>
#include <cstdint>
namespace pg8 {
#define PG8_LAS __attribute__((address_space(3)))
typedef unsigned short bf16_t;
typedef short bf16x8 __attribute__((ext_vector_type(8)));
typedef float f32x4 __attribute__((ext_vector_type(4)));
typedef unsigned u32x4 __attribute__((ext_vector_type(4)));
constexpr int BM = 256, BK = 64, HALF = 128, HTB = HALF * BK * 2  , STAGE_BYTES = 8 * HTB, NXCD = 8, WGM = 8;

__host__ __device__ __forceinline__ int lds_byte(int r, int c) { const int st = (r >> 4) * 2 + (c >> 5), rr = r & 15, cc = c & 31, ob = rr * 64 + cc * 2; return st * 1024 + (ob ^ (((ob >> 9) & 1) << 5)); }
__host__ __device__ __forceinline__ void stage_rc(int b, int& R, int& C) { const int st = b / 1024, sb = b % 1024, swz = sb ^ (((sb >> 9) & 1) << 5); R = (st >> 1) * 16 + swz / 64; C = (st & 1) * 32 + (swz % 64) / 2; }
__host__ __device__ __forceinline__ int perm32(int rho) { const int n = rho >> 4, i = rho & 15; return 8 * (i >> 2) + 4 * n + (i & 3); }

struct Unit { int pm, pn, k0, nk, part; };
struct Gemm { const bf16_t* A; const bf16_t* Bt; int M, N, K; };

struct StaticOrder {
    int nM, nN, nwg, G, c, nkt;
    __host__ __device__ void init(int M, int N, int G_, int c_, int K) { nM = M / BM; nN = N / BM; nwg = nM * nN; G = G_; c = c_; nkt = K / BK; }
    __host__ __device__ bool next(int i, Unit& u) const {
        const long L = (long)i * G + c; if (L >= nwg) return false;
        int wgid = (int)L; { const int q = nwg / NXCD, r = nwg % NXCD, xcd = wgid % NXCD, off = wgid / NXCD; wgid = (xcd < r ? xcd * (q + 1) : r * (q + 1) + (xcd - r) * q) + off; }
        const int nig = WGM * nN, gid = wgid / nig, fm = gid * WGM, gsz = (nM - fm) < WGM ? (nM - fm) : WGM;
        u.pm = fm + ((wgid % nig) % gsz); u.pn = (wgid % nig) / gsz; u.k0 = 0; u.nk = nkt; u.part = -1; return true;
    }
    __device__ __forceinline__ void a_ready(const Unit&) const {}
    __device__ __forceinline__ void done(const Unit&) const {}
};
struct SplitOrder {
    StaticOrder full; int S, base, extra, nsub, sp_pm0, sp_npn, sp_pn0;
    __host__ __device__ void init(int Mfull, int Nfull, int G_, int c_, int K, int S_, int ntiles_split, int pm0, int npn, int pn0) {
        full.init(Mfull, Nfull, G_, c_, K); S = S_; const int nk = K / BK; base = 2 * (nk / (2 * S)); extra = (nk - base * S) / 2; nsub = ntiles_split * S; sp_pm0 = pm0; sp_npn = npn; sp_pn0 = pn0; }
    __host__ __device__ bool next(int i, Unit& u) const {
        const int cs = (full.c - full.nwg % full.G + full.G) % full.G;
        const int ns = cs < nsub ? (nsub - cs + full.G - 1) / full.G : 0;
        if (i >= ns) return full.next(i - ns, u);
        const int j = i * full.G + cs;
        const int ti = j / S, s = j - ti * S;
        u.pm = sp_pm0 + ti / sp_npn; u.pn = sp_pn0 + ti % sp_npn; u.k0 = base * s + 2 * (s < extra ? s : extra); u.nk = base + (s < extra ? 2 : 0); u.part = s; return true;
    }
    __device__ __forceinline__ void a_ready(const Unit&) const {}
    __device__ __forceinline__ void done(const Unit&) const {}
};

typedef float f32x2c __attribute__((ext_vector_type(2))); typedef __bf16 bf16x2c __attribute__((ext_vector_type(2)));
__device__ __forceinline__ unsigned cvt_pk_bf16(float lo, float hi) { const f32x2c v = {lo, hi}; return __builtin_bit_cast(unsigned, __builtin_convertvector(v, bf16x2c)); }
typedef float f32x2 __attribute__((ext_vector_type(2)));
typedef unsigned u32x2 __attribute__((ext_vector_type(2)));
constexpr int E_MP = 8192;
constexpr int E_NMOD = 9 * 4096;
__device__ __forceinline__ int e_sidx(int r) { return r < E_MP ? 0 : 1 + ((r - E_MP) >> 6); }
__device__ __forceinline__ int e_pos(int r) { return r < E_MP ? r : 2048 + ((r - E_MP) & 63); }
__device__ __forceinline__ float silu_f(float g) { return g * __builtin_amdgcn_rcpf(1.0f + __builtin_amdgcn_exp2f(-1.4426950408889634f * g)); }

struct EpiSwiglu {
    static constexpr bool PERM = true, AFTER_DRAIN = false;
    bf16_t* O; int ldc;
    __device__ __forceinline__ void operator()(const f32x4 (&acc)[2][2][4][2], const Unit& u, int wr, int wc, int fr, int fq) const {
        const int row0 = u.pm * BM + wr * 64 + fr, col0 = u.pn * HALF + wc * 32 + 8 * fq;
#pragma unroll
        for (int ai = 0; ai < 2; ++ai)
#pragma unroll
            for (int m = 0; m < 4; ++m) {
                bf16_t* rowp = O + (size_t)(row0 + ai * HALF + m * 16) * ldc + col0;
                const f32x4 g0 = acc[ai][0][m][0], g1 = acc[ai][0][m][1], u0 = acc[ai][1][m][0], u1 = acc[ai][1][m][1];
                f32x4 e0 = g0 * -1.4426950408889634f, e1 = g1 * -1.4426950408889634f;
#pragma unroll
                for (int i = 0; i < 4; ++i) { e0[i] = __builtin_amdgcn_exp2f(e0[i]); e1[i] = __builtin_amdgcn_exp2f(e1[i]); }
                f32x4 d0 = e0 + 1.0f, d1 = e1 + 1.0f;
#pragma unroll
                for (int i = 0; i < 4; ++i) { d0[i] = __builtin_amdgcn_rcpf(d0[i]); d1[i] = __builtin_amdgcn_rcpf(d1[i]); }
                const f32x4 r0 = (g0 * u0) * d0, r1 = (g1 * u1) * d1;
                u32x4 w;
                w.x = cvt_pk_bf16(r0[0], r0[1]); w.y = cvt_pk_bf16(r0[2], r0[3]); w.z = cvt_pk_bf16(r1[0], r1[1]); w.w = cvt_pk_bf16(r1[2], r1[3]);
                *(u32x4*)rowp = w;
            }
    }
};
__device__ __forceinline__ f32x4 bf_lo4(u32x2 w) { return (f32x4){__builtin_bit_cast(float, w.x << 16), __builtin_bit_cast(float, w.x & 0xffff0000u), __builtin_bit_cast(float, w.y << 16), __builtin_bit_cast(float, w.y & 0xffff0000u)}; }
template <bool XBF> struct EpiResid {
    static constexpr bool PERM = true, AFTER_DRAIN = false;
    const void* Xin; const float* gate; bf16_t* T; float gs; float* SL;
    __device__ __forceinline__ void operator()(const f32x4 (&acc)[2][2][4][2], const Unit& u, int wr, int wc, int fr, int fq) const {
        const int row0 = u.pm * BM + wr * 64 + fr, col0 = u.pn * BM + wc * 32 + 8 * fq;
        if (u.part >= 0) {
#pragma unroll
            for (int ai = 0; ai < 2; ++ai)
#pragma unroll
                for (int m = 0; m < 4; ++m) { float* sr = SL + ((size_t)u.part * 512 + (size_t)(row0 + ai * HALF + m * 16 - E_MP)) * 4096 + col0;
#pragma unroll
                    for (int bj = 0; bj < 2; ++bj) { *(f32x4*)(sr + bj * HALF) = acc[ai][bj][m][0]; *(f32x4*)(sr + bj * HALF + 4) = acc[ai][bj][m][1]; } }
            return;
        }
        f32x4 gv[2][2];
#pragma unroll
        for (int bj = 0; bj < 2; ++bj) { gv[bj][0] = *(const f32x4*)(gate + col0 + bj * HALF) * gs; gv[bj][1] = *(const f32x4*)(gate + col0 + bj * HALF + 4) * gs; }
#pragma unroll
        for (int ai = 0; ai < 2; ++ai) {
            f32x4 xf[4][2][2]; u32x4 xb[4][2];
#pragma unroll
            for (int m = 0; m < 4; ++m) { const size_t off = (size_t)(row0 + ai * HALF + m * 16) * 4096 + col0;
#pragma unroll
                for (int bj = 0; bj < 2; ++bj) {
                    if (XBF) xb[m][bj] = *(const u32x4*)((const bf16_t*)Xin + off + bj * HALF);
                    else { xf[m][bj][0] = *(const f32x4*)((const float*)Xin + off + bj * HALF); xf[m][bj][1] = *(const f32x4*)((const float*)Xin + off + bj * HALF + 4); } } }
            __builtin_amdgcn_sched_barrier(0);
#pragma unroll
            for (int m = 0; m < 4; ++m) { const size_t off = (size_t)(row0 + ai * HALF + m * 16) * 4096 + col0;
#pragma unroll
                for (int bj = 0; bj < 2; ++bj) {
                    f32x4 x0, x1;
                    if (XBF) { x0 = bf_lo4((u32x2){xb[m][bj].x, xb[m][bj].y}); x1 = bf_lo4((u32x2){xb[m][bj].z, xb[m][bj].w}); } else { x0 = xf[m][bj][0]; x1 = xf[m][bj][1]; }
                    const f32x4 t0 = x0 * 1.189207115002721f + gv[bj][0] * acc[ai][bj][m][0], t1 = x1 * 1.189207115002721f + gv[bj][1] * acc[ai][bj][m][1];
                    u32x4 w; w.x = cvt_pk_bf16(t0[0], t0[1]); w.y = cvt_pk_bf16(t0[2], t0[3]); w.z = cvt_pk_bf16(t1[0], t1[1]); w.w = cvt_pk_bf16(t1[2], t1[3]);
                    *(u32x4*)(T + off + bj * HALF) = w;
                } }
            __builtin_amdgcn_sched_barrier(0);
        }
    }
};
struct EpiWin {
    static constexpr bool PERM = true, AFTER_DRAIN = false;
    bf16_t* U; bf16_t* Z; float* KRS;
    __device__ __forceinline__ void operator()(const f32x4 (&acc)[2][2][4][2], const Unit& u, int wr, int wc, int fr, int fq) const {
        const int row0 = u.pm * BM + wr * 64 + fr, col0 = u.pn * BM + wc * 32 + 8 * fq;
        if (u.part >= 0) {
            if (wc < 2) {
#pragma unroll
                for (int ai = 0; ai < 2; ++ai)
#pragma unroll
                    for (int m = 0; m < 4; ++m) { float* sr = KRS + ((size_t)u.part * 8704 + (size_t)(row0 + ai * HALF + m * 16)) * 64 + wc * 32 + 8 * fq;
                        *(f32x4*)sr = acc[ai][0][m][0]; *(f32x4*)(sr + 4) = acc[ai][0][m][1]; }
            }
            return;
        }
        bf16_t* base; int ld, c;
        if (u.pn < 8) { base = U; ld = 2048; c = col0; } else { base = Z; ld = 3584; c = col0 - 2048; }
#pragma unroll
        for (int ai = 0; ai < 2; ++ai)
#pragma unroll
            for (int m = 0; m < 4; ++m) { bf16_t* rowp = base + (size_t)(row0 + ai * HALF + m * 16) * ld + c;
#pragma unroll
                for (int bj = 0; bj < 2; ++bj) { const f32x4 v0 = acc[ai][bj][m][0], v1 = acc[ai][bj][m][1]; u32x4 w;
                    w.x = cvt_pk_bf16(v0[0], v0[1]); w.y = cvt_pk_bf16(v0[2], v0[3]); w.z = cvt_pk_bf16(v1[0], v1[1]); w.w = cvt_pk_bf16(v1[2], v1[3]);
                    *(u32x4*)(rowp + bj * HALF) = w; } }
    }
};
struct EpiHeads {
    static constexpr bool PERM = true, AFTER_DRAIN = false;
    bf16_t* O; float scale; int rope_tile0; const float* rope;
    __device__ __forceinline__ void operator()(const f32x4 (&acc)[2][2][4][2], const Unit& u, int wr, int wc, int fr, int fq) const {
        const int row0 = u.pm * BM + wr * 64 + fr;
        if (u.pn < rope_tile0) {
#pragma unroll
            for (int ai = 0; ai < 2; ++ai)
#pragma unroll
                for (int m = 0; m < 4; ++m) { bf16_t* rowp = O + (size_t)(row0 + ai * HALF + m * 16) * 3072 + wc * 32 + 8 * fq;
#pragma unroll
                    for (int bj = 0; bj < 2; ++bj) { const f32x4 v0 = acc[ai][bj][m][0] * scale, v1 = acc[ai][bj][m][1] * scale; u32x4 w;
                        w.x = cvt_pk_bf16(v0[0], v0[1]); w.y = cvt_pk_bf16(v0[2], v0[3]); w.z = cvt_pk_bf16(v1[0], v1[1]); w.w = cvt_pk_bf16(v1[2], v1[3]);
                        *(u32x4*)(rowp + (2 * u.pn + bj) * 192) = w; } }
        } else {
            const int head = 4 * (u.pn - rope_tile0) + wc, i0 = 8 * fq;
#pragma unroll
            for (int am = 0; am < 4; ++am) {
                const int ai = am >> 1;
                f32x4 rc[2][4];
#pragma unroll
                for (int mm = 0; mm < 2; ++mm) { const int m = 2 * (am & 1) + mm; const float* rp = rope + (size_t)e_pos(row0 + ai * HALF + m * 16) * 64 + i0;
                    rc[mm][0] = *(const f32x4*)rp; rc[mm][1] = *(const f32x4*)(rp + 4); rc[mm][2] = *(const f32x4*)(rp + 32); rc[mm][3] = *(const f32x4*)(rp + 36); }
                __builtin_amdgcn_sched_barrier(0);
#pragma unroll
                for (int mm = 0; mm < 2; ++mm) { const int m = 2 * (am & 1) + mm; const int row = row0 + ai * HALF + m * 16;
                    const f32x4 c0 = rc[mm][0], c1 = rc[mm][1], s0 = rc[mm][2], s1 = rc[mm][3];
                    const f32x4 a0 = acc[ai][0][m][0], a1 = acc[ai][0][m][1], b0 = acc[ai][1][m][0], b1 = acc[ai][1][m][1];
                    const f32x4 o10 = (a0 * c0 - b0 * s0) * scale, o11 = (a1 * c1 - b1 * s1) * scale, o20 = (b0 * c0 + a0 * s0) * scale, o21 = (b1 * c1 + a1 * s1) * scale;
                    bf16_t* rowp = O + (size_t)row * 3072 + head * 192 + 128 + i0; u32x4 w;
                    w.x = cvt_pk_bf16(o10[0], o10[1]); w.y = cvt_pk_bf16(o10[2], o10[3]); w.z = cvt_pk_bf16(o11[0], o11[1]); w.w = cvt_pk_bf16(o11[2], o11[3]); *(u32x4*)rowp = w;
                    w.x = cvt_pk_bf16(o20[0], o20[1]); w.y = cvt_pk_bf16(o20[2], o20[3]); w.z = cvt_pk_bf16(o21[0], o21[1]); w.w = cvt_pk_bf16(o21[2], o21[3]); *(u32x4*)(rowp + 32) = w; }
                __builtin_amdgcn_sched_barrier(0);
            }
        }
    }
};
struct EpiVt {
    static constexpr bool PERM = false, AFTER_DRAIN = false;
    bf16_t* VTP; bf16_t* VTS;
    __device__ __forceinline__ void operator()(const f32x4 (&acc)[2][2][4][2], const Unit& u, int wr, int wc, int fr, int fq) const {
        const int f0 = u.pm * BM + wr * 64 + fr, sw = ((fq & 1) << 1) | (fq >> 1);
#pragma unroll
        for (int bj = 0; bj < 2; ++bj)
#pragma unroll
            for (int n = 0; n < 2; ++n) {
                const int tok = u.pn * BM + bj * HALF + wc * 32 + n * 16;
                bf16_t* base; int stride;
                if (tok < E_MP) { base = VTP + tok + 4 * sw; stride = 8192; }
                else { const int t2 = tok - E_MP, b = t2 / 2112, j = t2 - b * 2112; base = VTS + (size_t)b * 2048 * 2112 + j + 4 * sw; stride = 2112; }
#pragma unroll
                for (int ai = 0; ai < 2; ++ai)
#pragma unroll
                    for (int m = 0; m < 4; ++m) { const f32x4 v = acc[ai][bj][m][n]; u32x2 w; w.x = cvt_pk_bf16(v[0], v[1]); w.y = cvt_pk_bf16(v[2], v[3]);
                        *(u32x2*)(base + (size_t)(f0 + ai * HALF + m * 16) * stride) = w; }
            }
    }
};
template <class Epi, class Sched, bool ALIGN_EPI = false, bool SP2 = false>
__device__ __forceinline__ void gemm_phase(PG8_LAS unsigned char* lds, const Gemm g, const Sched& S, const Epi& E, const int tid) {
    const int wid = __builtin_amdgcn_readfirstlane(tid >> 6), lane = tid & 63, wr = wid >> 2, wc = wid & 3, fr = lane & 15, fq = lane >> 4;
    const int K = g.K;
    unsigned voffA[2], voffB[2];
#pragma unroll
    for (int i = 0; i < 2; ++i) { int R, C; stage_rc(tid * 16 + i * 8192, R, C); const int Rb = Epi::PERM ? ((R & ~31) + perm32(R & 31)) : R;
        voffA[i] = (unsigned)(R * K + C) * 2u; voffB[i] = (unsigned)(Rb * K + C) * 2u; }
    const unsigned kstep = (unsigned)(BK * 2);
    const unsigned hstep = (unsigned)HALF * (unsigned)K * 2u;
    const unsigned tstep = 2u * hstep;
    const __amdgpu_buffer_rsrc_t rsA = __builtin_amdgcn_make_buffer_rsrc((void*)g.A, (short)0, 0x7fffffff, 0x00020000), rsB = __builtin_amdgcn_make_buffer_rsrc((void*)g.Bt, (short)0, 0x7fffffff, 0x00020000);
    const unsigned ldsw = (unsigned)wid * 1024u;
    const int aoff = lds_byte(wr * 64 + fr, fq * 8), boff = lds_byte(wc * 32 + fr, fq * 8);
#define PG8_SA(b, h) (((b) * 2 + (h)) * HTB)
#define PG8_SB(b, h) ((4 + (b) * 2 + (h)) * HTB)
#define PG8_STAGEX(rs, bufoff, goff, voff) do { _Pragma("unroll") for (int _i = 0; _i < 2; ++_i) \
        __builtin_amdgcn_raw_ptr_buffer_load_lds(rs, (PG8_LAS unsigned*)(lds + (bufoff) + ldsw + _i * 8192), 16, (int)(voff)[_i], (int)(goff), 0, 0); } while (0)
#define PG8_LDA(dst, b, h) do { _Pragma("unroll") for (int m = 0; m < 4; ++m) _Pragma("unroll") for (int k = 0; k < 2; ++k) dst[m][k] = *(const PG8_LAS bf16x8*)(lds + PG8_SA(b, h) + aoff + m * 2048 + k * 1024); } while (0)
#define PG8_LDB(dst, b, h) do { _Pragma("unroll") for (int n = 0; n < 2; ++n) _Pragma("unroll") for (int k = 0; k < 2; ++k) dst[n][k] = *(const PG8_LAS bf16x8*)(lds + PG8_SB(b, h) + boff + n * 2048 + k * 1024); } while (0)
#define PG8_MMA(ai, bj, At, Bt) do { __builtin_amdgcn_s_setprio(1); _Pragma("unroll") for (int m = 0; m < 4; ++m) _Pragma("unroll") for (int n = 0; n < 2; ++n) _Pragma("unroll") for (int k = 0; k < 2; ++k) \
        acc[ai][bj][m][n] = __builtin_amdgcn_mfma_f32_16x16x32_bf16(Bt[n][k], At[m][k], acc[ai][bj][m][n], 0, 0, 0); __builtin_amdgcn_s_setprio(0); } while (0)
#define PG8_WAIT_V(n) asm volatile("s_waitcnt vmcnt(" #n ")" ::: "memory")
#define PG8_WAIT_L(n) asm volatile("s_waitcnt lgkmcnt(" #n ")" ::: "memory")
#define PG8_BAR __builtin_amdgcn_s_barrier()
#define PG8_SCHED __builtin_amdgcn_sched_barrier(0)
    Unit cur, nxt; int ui = 0;
    if (!S.next(0, cur)) return;
    f32x4 acc[2][2][4][2];
#pragma unroll
    for (int a = 0; a < 2; ++a)
#pragma unroll
        for (int b = 0; b < 2; ++b)
#pragma unroll
            for (int m = 0; m < 4; ++m)
#pragma unroll
                for (int n = 0; n < 2; ++n) acc[a][b][m][n] = (f32x4){0.f, 0.f, 0.f, 0.f};
    bf16x8 At[4][2], B0[2][2], B1[2][2];
    unsigned cA = (unsigned)cur.pm * tstep + (unsigned)cur.k0 * kstep, cB = (unsigned)cur.pn * tstep + (unsigned)cur.k0 * kstep;
    S.a_ready(cur);
    if constexpr (SP2) {
        PG8_STAGEX(rsB, PG8_SB(0, 0), cB, voffB); PG8_STAGEX(rsB, PG8_SB(0, 1), cB + hstep, voffB); PG8_STAGEX(rsA, PG8_SA(0, 0), cA, voffA); PG8_STAGEX(rsA, PG8_SA(0, 1), cA + hstep, voffA);
        if (wr == 1) PG8_BAR;
        PG8_WAIT_V(2); PG8_BAR;
        PG8_STAGEX(rsB, PG8_SB(1, 0), cB + kstep, voffB); PG8_STAGEX(rsA, PG8_SA(1, 0), cA + kstep, voffA); PG8_STAGEX(rsB, PG8_SB(1, 1), cB + hstep + kstep, voffB);
        PG8_WAIT_V(6); PG8_BAR;
    } else {
        PG8_STAGEX(rsB, PG8_SB(0, 0), cB, voffB); PG8_STAGEX(rsA, PG8_SA(0, 0), cA, voffA); PG8_STAGEX(rsB, PG8_SB(0, 1), cB + hstep, voffB); PG8_STAGEX(rsA, PG8_SA(0, 1), cA + hstep, voffA);
        if (wr == 1) PG8_BAR;
        PG8_WAIT_V(4); PG8_BAR;
        PG8_STAGEX(rsB, PG8_SB(1, 0), cB + kstep, voffB); PG8_STAGEX(rsA, PG8_SA(1, 0), cA + kstep, voffA); PG8_STAGEX(rsB, PG8_SB(1, 1), cB + hstep + kstep, voffB);
        PG8_WAIT_V(6); PG8_BAR;
    }
    for (;;) {
        const bool has_next = S.next(ui + 1, nxt);
        const unsigned nA = has_next ? (unsigned)nxt.pm * tstep + (unsigned)nxt.k0 * kstep : cA, nB = has_next ? (unsigned)nxt.pn * tstep + (unsigned)nxt.k0 * kstep : cB;
        const int nt = cur.nk;
        for (int t = 0; t < nt; t += 2) {
            const bool last = (t == nt - 2);
            const unsigned a1 = cA + (unsigned)(t + 1) * kstep;
            const unsigned a2 = last ? nA : cA + (unsigned)(t + 2) * kstep, b2 = last ? nB : cB + (unsigned)(t + 2) * kstep;
            const unsigned a3 = a2 + kstep, b3 = b2 + kstep;
            if (last && has_next) S.a_ready(nxt);
            if constexpr (SP2) {
            PG8_LDB(B0, 0, 0); PG8_LDB(B1, 0, 1); PG8_SCHED; PG8_LDA(At, 0, 0); PG8_STAGEX(rsA, PG8_SA(1, 1), a1 + hstep, voffA);
            PG8_WAIT_V(8); PG8_WAIT_L(0); PG8_BAR; PG8_MMA(0, 0, At, B0); PG8_MMA(0, 1, At, B1); PG8_BAR; PG8_SCHED;
            PG8_LDA(At, 0, 1); PG8_STAGEX(rsB, PG8_SB(0, 0), b2, voffB); PG8_STAGEX(rsB, PG8_SB(0, 1), b2 + hstep, voffB); PG8_STAGEX(rsA, PG8_SA(0, 0), a2, voffA);
            PG8_WAIT_V(8); PG8_WAIT_L(0); PG8_BAR; PG8_MMA(1, 0, At, B0); PG8_MMA(1, 1, At, B1); PG8_BAR; PG8_SCHED;
            PG8_LDB(B0, 1, 0); PG8_LDB(B1, 1, 1); PG8_SCHED; PG8_LDA(At, 1, 0); PG8_STAGEX(rsA, PG8_SA(0, 1), a2 + hstep, voffA);
            PG8_WAIT_V(8); PG8_WAIT_L(0); PG8_BAR; PG8_MMA(0, 0, At, B0); PG8_MMA(0, 1, At, B1); PG8_BAR; PG8_SCHED;
            PG8_LDA(At, 1, 1); PG8_STAGEX(rsB, PG8_SB(1, 0), b3, voffB); PG8_STAGEX(rsB, PG8_SB(1, 1), b3 + hstep, voffB); PG8_STAGEX(rsA, PG8_SA(1, 0), a3, voffA);
            PG8_WAIT_V(8); PG8_WAIT_L(0); PG8_BAR; PG8_MMA(1, 0, At, B0); PG8_MMA(1, 1, At, B1); PG8_BAR; PG8_SCHED;
            } else {
            PG8_LDB(B0, 0, 0); PG8_SCHED; PG8_LDA(At, 0, 0); PG8_STAGEX(rsA, PG8_SA(1, 1), a1 + hstep, voffA);
            PG8_WAIT_L(8); PG8_BAR; PG8_WAIT_L(0); PG8_MMA(0, 0, At, B0); PG8_BAR; PG8_SCHED;
            PG8_LDB(B1, 0, 1); PG8_STAGEX(rsB, PG8_SB(0, 0), b2, voffB);
            PG8_BAR; PG8_WAIT_L(0); PG8_MMA(0, 1, At, B1); PG8_BAR;
            PG8_LDA(At, 0, 1); PG8_STAGEX(rsA, PG8_SA(0, 0), a2, voffA);
            PG8_BAR; PG8_WAIT_L(0); PG8_MMA(1, 0, At, B0); PG8_BAR; PG8_SCHED;
            PG8_STAGEX(rsB, PG8_SB(0, 1), b2 + hstep, voffB);
            PG8_WAIT_V(6); PG8_BAR; PG8_MMA(1, 1, At, B1); PG8_BAR;
            PG8_LDB(B0, 1, 0); PG8_SCHED; PG8_LDA(At, 1, 0); PG8_STAGEX(rsA, PG8_SA(0, 1), a2 + hstep, voffA);
            PG8_WAIT_L(8); PG8_BAR; PG8_WAIT_L(0); PG8_MMA(0, 0, At, B0); PG8_BAR; PG8_SCHED;
            PG8_LDB(B1, 1, 1); PG8_STAGEX(rsB, PG8_SB(1, 0), b3, voffB);
            PG8_BAR; PG8_WAIT_L(0); PG8_MMA(0, 1, At, B1); PG8_BAR;
            PG8_LDA(At, 1, 1); PG8_STAGEX(rsA, PG8_SA(1, 0), a3, voffA);
            PG8_BAR; PG8_WAIT_L(0); PG8_MMA(1, 0, At, B0); PG8_BAR; PG8_SCHED;
            PG8_STAGEX(rsB, PG8_SB(1, 1), b3 + hstep, voffB);
            PG8_WAIT_V(6); PG8_BAR; PG8_MMA(1, 1, At, B1); PG8_BAR;
            }
        }
        if constexpr (ALIGN_EPI) { if (wr == 0) PG8_BAR; }
        if constexpr (!Epi::AFTER_DRAIN) { E(acc, cur, wr, wc, fr, fq); S.done(cur); }
        if (!has_next) break;
#pragma unroll
        for (int a = 0; a < 2; ++a)
#pragma unroll
            for (int b = 0; b < 2; ++b)
#pragma unroll
                for (int m = 0; m < 4; ++m)
#pragma unroll
                    for (int n = 0; n < 2; ++n) acc[a][b][m][n] = (f32x4){0.f, 0.f, 0.f, 0.f};
        cur = nxt; cA = nA; cB = nB; ++ui;
        if constexpr (ALIGN_EPI) { if (wr == 1) PG8_BAR; }
    }
    PG8_WAIT_V(0);
    if constexpr (!ALIGN_EPI) { if (wr == 0) PG8_BAR; }
    PG8_BAR;
    if constexpr (Epi::AFTER_DRAIN) { E.fused(acc, cur, wr, wc, fr, fq, lds, wid, lane); S.done(cur); }
#undef PG8_SA
#undef PG8_SB
#undef PG8_STAGEX
#undef PG8_LDA
#undef PG8_LDB
#undef PG8_MMA
#undef PG8_WAIT_V
#undef PG8_WAIT_L
#undef PG8_BAR
#undef PG8_SCHED
}
}

constexpr int NWAVES = 8;
constexpr int DM = 4096, MP = 8192, NB = 8, DS = 64, MS = NB * DS, M = MP + MS, PAST = 2048, KS = PAST + DS  ;
constexpr int DFF = 11008, GW = 2048, NG = 16, NH = 16, KVR = 512, QR = 1024, INW = 5696, ZW = 3648, QW = 3072;
constexpr int LATROWS = MP + NB * KS;
constexpr int NMOD = 9 * DM;
constexpr float LN_EPS = 1e-5f, RMS_EPS = 1e-6f;
constexpr float QSCALE = 0.07216878364870322f * 1.4426950408889634f;
#ifndef MK_PER_PHASE
#define MK_PER_PHASE 0
#endif
constexpr int N_PHASES = 14;
constexpr int GATE_P7 = 2;

constexpr size_t MiB = 1u << 20;
constexpr size_t WS_CTL = 0, CTL_ZERO_BYTES = 1 * MiB;
constexpr size_t WS_MOD = 1 * MiB, WS_ROPE = 3 * MiB;
constexpr size_t WS_WGU1 = 8 * MiB, WS_WD1 = WS_WGU1 + 172 * MiB, WS_WGU2 = WS_WD1 + 86 * MiB, WS_WD2 = WS_WGU2 + 172 * MiB;
constexpr size_t WS_WIN = WS_WD2 + 86 * MiB, WS_WUQ = WS_WIN + 46 * MiB, WS_WUK = WS_WUQ + 6 * MiB, WS_WUV = WS_WUK + 2 * MiB, WS_WOUT = WS_WUV + 2 * MiB;
constexpr size_t WS_H = WS_WOUT + 32 * MiB, WS_ACT = WS_H + 68 * MiB, WS_T = WS_ACT + 183 * MiB, WS_X = WS_T + 136 * MiB;
constexpr size_t WS_U = WS_X + 136 * MiB, WS_Z = WS_U + 34 * MiB, WS_VN = WS_Z + 122 * MiB, WS_CQN = WS_VN + 34 * MiB, WS_LAT = WS_CQN + 17 * MiB;
constexpr size_t WS_Q = WS_LAT + 25 * MiB, WS_KALL = WS_Q + 51 * MiB, WS_VTP = WS_KALL + 147 * MiB, WS_VTS = WS_VTP + 32 * MiB, WS_MIX = WS_VTS + 66 * MiB;
constexpr size_t WS_SL = WS_MIX + 68 * MiB, WS_KRS = WS_SL + 64 * MiB;
constexpr size_t WS_END = WS_KRS + 17 * MiB;
constexpr int CW_TMO = 0, CW_QUEUE = 1024, CW_CONV = 1088, CW_GATEQ = 1280, CW_BAR = 4096;
constexpr size_t O_Y = 0, O_LATP = (size_t)M * DM, O_KRP = O_LATP + (size_t)MP * KVR, O_LATS = O_KRP + (size_t)MP * 64, O_KRS = O_LATS + (size_t)MS * KVR, O_VS = O_KRS + (size_t)MS * 64;

constexpr int RING_OFF = 0, RING_BYTES = 131072;
constexpr int LDSCTL_OFF = RING_BYTES, MISC_OFF = LDSCTL_OFF + 320;
constexpr int LDS_BYTES = 147456;

#define GAS __attribute__((address_space(1)))
#define LAS __attribute__((address_space(3)))
typedef unsigned short bf16;
typedef unsigned v4u __attribute__((ext_vector_type(4)));
typedef float f32x4 __attribute__((ext_vector_type(4)));
typedef short bf16x8 __attribute__((ext_vector_type(8)));
typedef GAS unsigned gu32;
typedef GAS unsigned long long gu64;
#define RLX_AGENT __ATOMIC_RELAXED, __HIP_MEMORY_SCOPE_AGENT
#define LDS_WAIT() asm volatile("s_waitcnt lgkmcnt(0)" ::: "memory")
#define VM_WAIT() asm volatile("s_waitcnt vmcnt(0)" ::: "memory")
__device__ __forceinline__ unsigned long long rt() { return __builtin_amdgcn_s_memrealtime(); }
__device__ __forceinline__ unsigned f2bf(float f) { unsigned u = __builtin_bit_cast(unsigned, f); return (u + 0x7fffu + ((u >> 16) & 1u)) >> 16; }
__device__ __forceinline__ unsigned pk2(float lo, float hi) { return f2bf(lo) | (f2bf(hi) << 16); }
#define XB_TMO      128
#define XB_XCNT(j)  (256  + 64 * (j))
#define XB_XSUB(j)  (1280 + 64 * (j))
#define XB_XGEN(j)  (2304 + 64 * (j))
#define XB_TOP      3328
#define XB_TOPGEN   3392
#define XCD_BAR_WORDS 3456
#define XB_SPIN_CAP (1u << 18)

__device__ __forceinline__ unsigned xb_ld(unsigned* p)              { return __hip_atomic_load(p, __ATOMIC_RELAXED, __HIP_MEMORY_SCOPE_AGENT); }
__device__ __forceinline__ unsigned xb_add(unsigned* p, unsigned v) { return __hip_atomic_fetch_add(p, v, __ATOMIC_RELAXED, __HIP_MEMORY_SCOPE_AGENT); }
__device__ __forceinline__ unsigned xb_xcc_id() { return (unsigned)__builtin_amdgcn_s_getreg((3 << 11) | 20) & 0xFu; }
#define XB_SPIN(cond, bar) do { unsigned _sp = 0; while (cond) { __builtin_amdgcn_s_sleep(1); \
    if ((++_sp & 255u) == 0u) { if (xb_ld(&(bar)[XB_TMO])) break; if (_sp > XB_SPIN_CAP) { atomicAdd(&(bar)[XB_TMO], 1u); break; } } } } while (0)

__device__ __forceinline__ int fresh_lane() { int l; asm volatile("v_mbcnt_lo_u32_b32 %0, -1, 0\n\tv_mbcnt_hi_u32_b32 %0, -1, %0" : "=v"(l)); return l; }
struct XcdBarrier {
    unsigned* bar; unsigned x; int w0;
    volatile LAS unsigned* st;
};

__device__ __forceinline__ XcdBarrier xcd_barrier_post(unsigned* bar, volatile LAS unsigned* st, int wave) {
    XcdBarrier b; b.bar = bar; b.x = xb_xcc_id(); b.st = st; b.w0 = (wave == 0);
    if (b.w0 && fresh_lane() == 0) (void)xb_add(&bar[XB_XCNT(b.x)], 1u);
    return b;
}
__device__ __forceinline__ void xcd_barrier_complete(unsigned* bar, unsigned x, unsigned& nloc, unsigned& nx) {
    const unsigned G = gridDim.x * gridDim.y * gridDim.z;
    unsigned sum, cnt, mine, sp = 0u;
    for (;;) {
        sum = 0u; cnt = 0u; mine = 0u;
#pragma unroll
        for (unsigned j = 0; j < 16; ++j) { const unsigned c = xb_ld(&bar[XB_XCNT(j)]); sum += c; cnt += (c > 0u) ? 1u : 0u; mine = (j == x) ? c : mine; }
        if (sum == G) break;
        __builtin_amdgcn_s_sleep(1);
        if ((++sp & 255u) == 0u) { if (xb_ld(&bar[XB_TMO])) break; if (sp > XB_SPIN_CAP) { atomicAdd(&bar[XB_TMO], 1u); break; } }
    }
    nloc = mine > 0u ? mine : 1u; nx = cnt > 0u ? cnt : 1u;
}

__device__ __forceinline__ void xcd_barrier(const XcdBarrier& b) {
    asm volatile("s_waitcnt vmcnt(0)" ::: "memory");
    __syncthreads();
    if (b.w0 && fresh_lane() == 0) {
        unsigned* bar = b.bar;
        __builtin_amdgcn_s_waitcnt(0);
        unsigned nloc = b.st[0], nx = b.st[1];
        if (nloc == 0u) { xcd_barrier_complete(bar, b.x, nloc, nx); b.st[0] = nloc; b.st[1] = nx; }
        const unsigned old = xb_add(&bar[XB_XSUB(b.x)], 1u);
        const unsigned gen = old / nloc;
        if (old + 1u == (gen + 1u) * nloc) {
            __builtin_amdgcn_fence(__ATOMIC_RELEASE, "agent");
            asm volatile("s_waitcnt vmcnt(0)" ::: "memory");
            const unsigned og = xb_add(&bar[XB_TOP], 1u);
            const unsigned tg = og / nx;
            if (og + 1u == (tg + 1u) * nx) xb_add(&bar[XB_TOPGEN], 1u);
            else XB_SPIN(xb_ld(&bar[XB_TOPGEN]) == tg, bar);
            __builtin_amdgcn_fence(__ATOMIC_ACQUIRE, "agent");
            xb_add(&bar[XB_XGEN(b.x)], 1u);
            asm volatile("s_waitcnt vmcnt(0)" ::: "memory");
        } else {
            XB_SPIN(xb_ld(&bar[XB_XGEN(b.x)]) == gen, bar);
            __builtin_amdgcn_fence(__ATOMIC_ACQUIRE, "agent");
            asm volatile("s_waitcnt vmcnt(0)" ::: "memory");
        }
    }
    __syncthreads();
}


struct Frame {
    LAS unsigned char* lds;
    volatile LAS unsigned* MISC;
    gu32* ctl;
    int tid, lane, wave, vcu, G;
};
__device__ __forceinline__ float wave_sum(float v) {
#pragma unroll
    for (int o = 1; o < 64; o <<= 1) v += __shfl_xor(v, o);
    return v;
}
__device__ __forceinline__ int r_sidx(int r) { return r < MP ? 0 : 1 + ((r - MP) >> 6); }
__device__ __forceinline__ int r_pos(int r) { return r < MP ? r : PAST + ((r - MP) & 63); }
__device__ __forceinline__ int r_keyrow(int r) { return r < MP ? r : MP + ((r - MP) >> 6) * KS + PAST + ((r - MP) & 63); }

__device__ __forceinline__ void transpose_item(const float* W, int K, int N, bf16* WT, int k0, int n0, int rowA, int rowB, LAS unsigned char* tile, int lane) {
    const int l15 = lane & 15, lq = lane >> 4;
    f32x4 v[16];
    const float* src = W + (size_t)(k0 + 2 * lq) * N + n0 + 4 * l15;
#pragma unroll
    for (int i = 0; i < 16; ++i) v[i] = *(const f32x4*)(src + (size_t)(8 * (i >> 1) + (i & 1)) * N);
#pragma unroll
    for (int p = 0; p < 8; ++p)
#pragma unroll
        for (int e = 0; e < 4; ++e) { const int n = 4 * l15 + e;
            *(LAS unsigned*)(tile + n * 128 + (((p ^ (l15 & 7)) << 4) | (4 * lq))) = pg8::cvt_pk_bf16(v[2 * p][e], v[2 * p + 1][e]); }
    LDS_WAIT(); asm volatile("" ::: "memory");
#pragma unroll
    for (int j = 0; j < 8; ++j) { const int n = (lane >> 3) + 8 * j, c = lane & 7;
        const v4u o = *(const LAS v4u*)(tile + n * 128 + ((c ^ ((n >> 2) & 7)) << 4));
        const int row = (n < 32 ? rowA : rowB - 32) + n;
        *(GAS v4u*)(WT + (size_t)row * K + k0 + 8 * c) = o; }
    LDS_WAIT(); asm volatile("" ::: "memory");
}
__device__ __forceinline__ int map_gu(int n0) { const int up = n0 >= DFF, j = up ? n0 - DFF : n0; return 256 * (j >> 7) + (up ? 128 : 0) + (j & 127); }
__device__ __forceinline__ int map_uq(int n0) { const int head = n0 / 192, e = n0 - head * 192;
    if (e < 128) return head * 128 + e;
    return 2048 + 256 * (head >> 2) + (e >= 160 ? 128 : 0) + 32 * (head & 3) + (e & 31); }
__device__ __forceinline__ int map_ukv(int n0) { const int head = n0 >> 8, e = n0 & 255; return (e < 128 ? 0 : 2048) + head * 128 + (e & 127); }

template <int MAP> __device__ __forceinline__ void transpose_matrix(Frame& F, const float* W, int K, int N, bf16* WT, int& it0) {
    LAS unsigned char* tile = F.lds + RING_OFF + F.wave * 8192;
    const int gw = F.vcu * NWAVES + F.wave, NGW = F.G * NWAVES;
    const int nblk = N / 64, nitems = (K / 64) * nblk;
    int first = (gw - (it0 % NGW) + NGW) % NGW;
    for (int it = first; it < nitems; it += NGW) {
        const int kb = it / nblk, nb = it - kb * nblk, n0 = 64 * nb;
        const int rowA = MAP == 1 ? map_gu(n0) : MAP == 2 ? map_uq(n0) : MAP == 3 ? map_ukv(n0) : n0;
        const int rowB = MAP == 1 ? map_gu(n0 + 32) : MAP == 2 ? map_uq(n0 + 32) : MAP == 3 ? map_ukv(n0 + 32) : n0 + 32;
        transpose_item(W, K, N, WT, 64 * kb, n0, rowA, rowB, tile, F.lane);
    }
    it0 += nitems;
}

struct ConvMat { const float* W; bf16* WT; int K, N, map; };
struct ConvIt { const float* W; bf16* WT; int K, N, k0, n0, rowA, rowB; };
constexpr int CONV0_ITEMS = 11008 + 5696 + 768 + 512 + 4096 + 22016, CONV1_ITEMS = 11008;
constexpr int CONV_BATCH = 64;
static_assert(CONV0_ITEMS % CONV_BATCH == 0 && CONV1_ITEMS % CONV_BATCH == 0, "conversion batches");
__device__ __forceinline__ ConvIt conv_decode(int group, int it, const float* const* in, unsigned char* ws) {
    ConvMat cm;
    if (group == 1) { cm = ConvMat{in[25], (bf16*)(ws + WS_WD2), DFF, DM, 0}; }
    else if (it < 11008) { cm = ConvMat{in[9], (bf16*)(ws + WS_WD1), DFF, DM, 0}; }
    else if (it < 16704) { it -= 11008; cm = ConvMat{in[12], (bf16*)(ws + WS_WIN), DM, INW, 0}; }
    else if (it < 17472) { it -= 16704; cm = ConvMat{in[18], (bf16*)(ws + WS_WUQ), QR, QW, 2}; }
    else if (it < 17984) { it -= 17472; cm = ConvMat{in[20], (bf16*)(ws + WS_WUK), KVR, 4096, 3}; }
    else if (it < 22080) { it -= 17984; cm = ConvMat{in[21], (bf16*)(ws + WS_WOUT), DM, DM, 0}; }
    else { it -= 22080; cm = ConvMat{in[24], (bf16*)(ws + WS_WGU2), DM, 2 * DFF, 1}; }
    const int nblk = cm.N / 64, kb = it / nblk, nb = it - kb * nblk, n0 = 64 * nb;
    int rowA = n0, rowB = n0 + 32;
    if (cm.map == 1) { rowA = map_gu(n0); rowB = map_gu(n0 + 32); } else if (cm.map == 2) { rowA = map_uq(n0); rowB = map_uq(n0 + 32); } else if (cm.map == 3) { rowA = map_ukv(n0); rowB = map_ukv(n0 + 32); }
    return ConvIt{cm.W, cm.WT, cm.K, cm.N, 64 * kb, n0, rowA, rowB};
}
__device__ __forceinline__ void tr_load(f32x4 (&v)[16], const ConvIt& ci, int lane) {
    const float* src = ci.W + (size_t)(ci.k0 + 2 * (lane >> 4)) * ci.N + ci.n0 + 4 * (lane & 15);
#pragma unroll
    for (int i = 0; i < 16; ++i) v[i] = __builtin_nontemporal_load((const f32x4*)(src + (size_t)(8 * (i >> 1) + (i & 1)) * ci.N));
    __builtin_amdgcn_sched_barrier(0);
}
__device__ __forceinline__ void tr_store(const f32x4 (&v)[16], const ConvIt& ci, LAS unsigned char* tile, int lane) {
    const int l15 = lane & 15, lq = lane >> 4;
#pragma unroll
    for (int p = 0; p < 8; ++p)
#pragma unroll
        for (int e = 0; e < 4; ++e) { const int n = 4 * l15 + e;
            *(LAS unsigned*)(tile + n * 128 + (((p ^ (l15 & 7)) << 4) | (4 * lq))) = pg8::cvt_pk_bf16(v[2 * p][e], v[2 * p + 1][e]); }
    LDS_WAIT(); asm volatile("" ::: "memory");
#pragma unroll
    for (int j = 0; j < 8; ++j) { const int n = (lane >> 3) + 8 * j, c = lane & 7;
        const v4u o = *(const LAS v4u*)(tile + n * 128 + ((c ^ ((n >> 2) & 7)) << 4));
        const int row = (n < 32 ? ci.rowA : ci.rowB - 32) + n;
        *(GAS v4u*)(ci.WT + (size_t)row * ci.K + ci.k0 + 8 * c) = o; }
    LDS_WAIT(); asm volatile("" ::: "memory");
    __builtin_amdgcn_sched_barrier(0);
}
__device__ __forceinline__ void conv_pull(Frame& F, int group, const float* const* in, unsigned char* ws) {
    const int nb = (group == 0 ? CONV0_ITEMS : CONV1_ITEMS) / CONV_BATCH;
    LAS unsigned char* tile = F.lds + RING_OFF + F.wave * 8192;
    for (;;) {
        if (F.tid == 0) F.MISC[1] = __hip_atomic_fetch_add(F.ctl + CW_CONV + 64 * group, 1u, __ATOMIC_RELAXED, __HIP_MEMORY_SCOPE_AGENT);
        LDS_WAIT(); __syncthreads();
        const int b = __builtin_amdgcn_readfirstlane((int)F.MISC[1]);
        __syncthreads();
        if (b >= nb) break;
        const int it0 = CONV_BATCH * b + F.wave;
        f32x4 va[16], vb[16];
        ConvIt ca = conv_decode(group, it0, in, ws), cb;
        tr_load(va, ca, F.lane);
#pragma unroll 1
        for (int j = 0; j < 8; j += 2) {
            cb = conv_decode(group, it0 + 8 * (j + 1), in, ws); tr_load(vb, cb, F.lane);
            tr_store(va, ca, tile, F.lane);
            if (j + 2 < 8) { ca = conv_decode(group, it0 + 8 * (j + 2), in, ws); tr_load(va, ca, F.lane); }
            tr_store(vb, cb, tile, F.lane);
        }
    }
}

__device__ __forceinline__ void mod_phase(Frame& F, const float* cp, const float* cs, const float* wada, const float* bada, float* mod) {
    LAS float* red = (LAS float*)(F.lds + RING_OFF);
    const int lane = F.lane, w = F.wave;
    for (int cb = F.vcu; cb < NMOD / 144; cb += F.G) {
        const int lc = lane < 36 ? lane : 35;
        const float* wrow = wada + (size_t)(512 * w) * NMOD + cb * 144;
        f32x4 acc[9];
#pragma unroll
        for (int b = 0; b < 9; ++b) acc[b] = (f32x4){0.f, 0.f, 0.f, 0.f};
        for (int kb = 0; kb < 8; ++kb) {
            float sv[9];
            { const int k = 512 * w + 64 * kb + lane;
#pragma unroll
              for (int b = 0; b < 9; ++b) { const float c = b == 0 ? cp[k] : cs[(b - 1) * DM + k]; sv[b] = c * __builtin_amdgcn_rcpf(1.0f + __builtin_amdgcn_exp2f(-1.4426950408889634f * c)); } }
#pragma unroll 1
            for (int k0 = 0; k0 < 64; k0 += 16) {
                f32x4 wv[16];
#pragma unroll
                for (int u = 0; u < 16; ++u) wv[u] = __builtin_nontemporal_load((const f32x4*)(wrow + (size_t)(64 * kb + k0 + u) * NMOD + 4 * lc));
                __builtin_amdgcn_sched_barrier(0);
#pragma unroll
                for (int u = 0; u < 16; ++u)
#pragma unroll
                    for (int b = 0; b < 9; ++b) { const float s = __builtin_bit_cast(float, __builtin_amdgcn_readlane(__builtin_bit_cast(int, sv[b]), k0 + u)); acc[b] += wv[u] * s; }
            }
        }
        if (lane < 36) {
#pragma unroll
            for (int b = 0; b < 9; ++b) *(LAS f32x4*)(red + (w * 9 + b) * 144 + 4 * lane) = acc[b];
        }
        LDS_WAIT(); __syncthreads();
        for (int o = F.tid; o < 9 * 144; o += NWAVES * 64) { const int b = o / 144, c = o - b * 144; float s = bada[cb * 144 + c];
#pragma unroll
            for (int ww = 0; ww < 8; ++ww) s += red[(ww * 9 + b) * 144 + c];
            mod[(size_t)b * NMOD + cb * 144 + c] = s; }
        __syncthreads();
    }
}
__device__ __forceinline__ void rope_phase(Frame& F, float* rope) {
    const int gt = F.vcu * (NWAVES * 64) + F.tid, NT = F.G * NWAVES * 64;
    for (int idx = gt; idx < MP * 32; idx += NT) {
        const int pos = idx >> 5, i = idx & 31;
        const double inv = exp2(-(double)i * (13.287712379549449 / 32.0));
        const double ang = (double)pos * inv;
        const double n = rint(ang * 0.15915494309189535);
        double r = fma(-n, 6.283185307179586, ang); r = fma(-n, 2.4492935982947064e-16, r);
        const float rf = (float)r;
        rope[(size_t)pos * 64 + i] = cosf(rf); rope[(size_t)pos * 64 + 32 + i] = sinf(rf);
    }
}
__device__ __forceinline__ void krope_store16(bf16* krow  , float v, int lane) {
    const unsigned mine = f2bf(v);
    unsigned e[8];
#pragma unroll
    for (int j = 0; j < 8; ++j) e[j] = (unsigned)__shfl((int)mine, 8 * (lane & 7) + j);
    v4u o; o.x = e[0] | (e[1] << 16); o.y = e[2] | (e[3] << 16); o.z = e[4] | (e[5] << 16); o.w = e[6] | (e[7] << 16);
    const int hg = lane >> 3, ch = lane & 7;
    *(GAS v4u*)(krow + hg * 192 + 128 + 8 * ch) = o;
    *(GAS v4u*)(krow + (hg + 8) * 192 + 128 + 8 * ch) = o;
}
__device__ __forceinline__ void cache_phase(Frame& F, const float* clat, const float* ckr, bf16* LAT, bf16* KALL) {
    const int gw = F.vcu * NWAVES + F.wave, NGW = F.G * NWAVES, lane = F.lane;
    for (int rr = gw; rr < NB * PAST; rr += NGW) {
        const int b = rr / PAST, j = rr - b * PAST; const size_t krow = (size_t)MP + (size_t)b * KS + j;
        const f32x4 a = *(const f32x4*)(clat + (size_t)rr * KVR + 8 * lane), c = *(const f32x4*)(clat + (size_t)rr * KVR + 8 * lane + 4);
        v4u o; o.x = pk2(a[0], a[1]); o.y = pk2(a[2], a[3]); o.z = pk2(c[0], c[1]); o.w = pk2(c[2], c[3]);
        *(GAS v4u*)(LAT + krow * KVR + 8 * lane) = o;
        krope_store16(KALL + krow * QW, ckr[(size_t)rr * 64 + lane], lane);
    }
}
__device__ __forceinline__ void modulate_rows(Frame& F, const float* xp, const float* xs, const float* mod, int ksh, bf16* H) {
    const int gw = F.vcu * NWAVES + F.wave, NGW = F.G * NWAVES, lane = F.lane;
    LAS float* PL = (LAS float*)(F.lds + RING_OFF + 1024);
    { const float* sh = mod + ksh * DM; const float* sc = sh + DM;
      for (int i = F.tid; i < DM / 4; i += NWAVES * 64) { *(LAS f32x4*)(PL + 4 * i) = *(const f32x4*)(sc + 4 * i) + 1.0f; *(LAS f32x4*)(PL + DM + 4 * i) = *(const f32x4*)(sh + 4 * i); }
      LDS_WAIT(); __syncthreads(); }
    for (int r = gw; r < M; r += NGW) {
        const float* x = r < MP ? xp + (size_t)r * DM : xs + (size_t)(r - MP) * DM;
        f32x4 xv[16];
#pragma unroll
        for (int j = 0; j < 16; ++j) xv[j] = *(const f32x4*)(x + 4 * lane + 256 * j);
        __builtin_amdgcn_sched_barrier(0);
        if (r < MP) {
#pragma unroll
            for (int j = 0; j < 16; ++j) { const int c = 4 * lane + 256 * j;
                const f32x4 h = xv[j] * *(const LAS f32x4*)(PL + c) + *(const LAS f32x4*)(PL + DM + c);
                unsigned long long o = (unsigned long long)pk2(h[0], h[1]) | ((unsigned long long)pk2(h[2], h[3]) << 32);
                *(GAS unsigned long long*)(H + (size_t)r * DM + c) = o; }
        } else {
            const float* sh = mod + (size_t)r_sidx(r) * NMOD + ksh * DM; const float* sc = sh + DM;
#pragma unroll
            for (int jj = 0; jj < 2; ++jj) { f32x4 a[8], s1[8];
#pragma unroll
                for (int j = 0; j < 8; ++j) { const int c = 4 * lane + 256 * (8 * jj + j); a[j] = *(const f32x4*)(sh + c); s1[j] = *(const f32x4*)(sc + c); }
                __builtin_amdgcn_sched_barrier(0);
#pragma unroll
                for (int j = 0; j < 8; ++j) { const int c = 4 * lane + 256 * (8 * jj + j); const f32x4 h = xv[8 * jj + j] * (s1[j] + 1.0f) + a[j];
                    unsigned long long o = (unsigned long long)pk2(h[0], h[1]) | ((unsigned long long)pk2(h[2], h[3]) << 32);
                    *(GAS unsigned long long*)(H + (size_t)r * DM + c) = o; } }
        }
    }
    __syncthreads();
}
__device__ __forceinline__ f32x4 ubf_lo(v4u w, int h) { const unsigned a = h ? w.z : w.x, b = h ? w.w : w.y;
    return (f32x4){__builtin_bit_cast(float, a << 16), __builtin_bit_cast(float, a & 0xffff0000u), __builtin_bit_cast(float, b << 16), __builtin_bit_cast(float, b & 0xffff0000u)}; }
__device__ __forceinline__ v4u pack8(f32x4 a, f32x4 b) { v4u o; o.x = pg8::cvt_pk_bf16(a[0], a[1]); o.y = pg8::cvt_pk_bf16(a[2], a[3]); o.z = pg8::cvt_pk_bf16(b[0], b[1]); o.w = pg8::cvt_pk_bf16(b[2], b[3]); return o; }
template <bool HAS_H, bool XS_F32, bool OUT_F32> __device__ __forceinline__ void ln_rows(Frame& F, const bf16* T, const float* g, const float* b, void* Xout, const float* mod, int ksh, bf16* H,
                                                                 const float* SL, const void* Xs, const float* gate, float gs) {
    const int gw = F.vcu * NWAVES + F.wave, NGW = F.G * NWAVES, lane = F.lane, w = F.wave;
    {
        LAS float* red = (LAS float*)(F.lds + RING_OFF);
        for (int rs = F.vcu; rs < MS; rs += F.G) {
            const int r = MP + rs, c0 = 512 * w + 8 * lane;
            const float* sl = SL + (size_t)rs * DM + c0; const float* gr = gate + (size_t)r_sidx(r) * NMOD + c0;
            f32x4 sa[8][2], x0, x1; v4u xw;
#pragma unroll
            for (int p = 0; p < 8; ++p) { sa[p][0] = *(const f32x4*)(sl + (size_t)p * MS * DM); sa[p][1] = *(const f32x4*)(sl + (size_t)p * MS * DM + 4); }
            if (XS_F32) { const float* xr = (const float*)Xs + (size_t)rs * DM + c0; x0 = *(const f32x4*)xr; x1 = *(const f32x4*)(xr + 4); }
            else xw = *(const GAS v4u*)((const bf16*)Xs + (size_t)rs * DM + c0);
            const f32x4 g0 = *(const f32x4*)gr, g1 = *(const f32x4*)(gr + 4);
            __builtin_amdgcn_sched_barrier(0);
            if (!XS_F32) { x0 = ubf_lo(xw, 0); x1 = ubf_lo(xw, 1); }
            f32x4 a0 = sa[0][0], a1 = sa[0][1];
#pragma unroll
            for (int p = 1; p < 8; ++p) { a0 += sa[p][0]; a1 += sa[p][1]; }
            f32x4 v0 = x0 * 1.189207115002721f + (g0 * gs) * a0, v1 = x1 * 1.189207115002721f + (g1 * gs) * a1;
            float s = ((v0[0] + v0[1]) + (v0[2] + v0[3])) + ((v1[0] + v1[1]) + (v1[2] + v1[3]));
            s = wave_sum(s); if (lane == 0) red[w] = s;
            LDS_WAIT(); __syncthreads();
            float tot = 0.f;
#pragma unroll
            for (int ww = 0; ww < 8; ++ww) tot += red[ww];
            const float mean = tot * (1.f / DM);
            v0 = v0 - mean; v1 = v1 - mean;
            float q = ((v0[0] * v0[0] + v0[1] * v0[1]) + (v0[2] * v0[2] + v0[3] * v0[3])) + ((v1[0] * v1[0] + v1[1] * v1[1]) + (v1[2] * v1[2] + v1[3] * v1[3]));
            q = wave_sum(q); if (lane == 0) red[8 + w] = q;
            LDS_WAIT(); __syncthreads();
            float tq = 0.f;
#pragma unroll
            for (int ww = 0; ww < 8; ++ww) tq += red[8 + ww];
            const float rstd = 1.0f / sqrtf(tq * (1.f / DM) + LN_EPS);
            const float* sh = mod + (size_t)r_sidx(r) * NMOD + ksh * DM + c0; const float* sc = sh + DM;
            const f32x4 pg0 = *(const f32x4*)(g + c0), pg1 = *(const f32x4*)(g + c0 + 4), pb0 = *(const f32x4*)(b + c0), pb1 = *(const f32x4*)(b + c0 + 4);
            f32x4 ps0 = pg0, ps1 = pg0, ph0 = pg0, ph1 = pg0;
            if (HAS_H) { ps0 = *(const f32x4*)sc; ps1 = *(const f32x4*)(sc + 4); ph0 = *(const f32x4*)sh; ph1 = *(const f32x4*)(sh + 4); }
            __builtin_amdgcn_sched_barrier(0);
            const f32x4 y0 = v0 * rstd * pg0 + pb0, y1 = v1 * rstd * pg1 + pb1;
            if (OUT_F32) { float* xo = (float*)Xout + (size_t)r * DM + c0; *(f32x4*)xo = y0; *(f32x4*)(xo + 4) = y1; }
            else *(GAS v4u*)((bf16*)Xout + (size_t)r * DM + c0) = pack8(y0, y1);
            if (HAS_H) { const f32x4 h0 = y0 * (ps0 + 1.0f) + ph0, h1 = y1 * (ps1 + 1.0f) + ph1;
                *(GAS v4u*)(H + (size_t)r * DM + c0) = pack8(h0, h1); }
            __syncthreads();
        }
    }
    LAS float* PL = (LAS float*)(F.lds + RING_OFF + 1024);
    { const float* sh = mod + ksh * DM; const float* sc = sh + DM;
      for (int i = F.tid; i < DM / 4; i += NWAVES * 64) { const f32x4 gv = *(const f32x4*)(g + 4 * i), bv = *(const f32x4*)(b + 4 * i);
          *(LAS f32x4*)(PL + 4 * i) = gv; *(LAS f32x4*)(PL + DM + 4 * i) = bv;
          if (HAS_H) { const f32x4 s1 = *(const f32x4*)(sc + 4 * i) + 1.0f, hv = *(const f32x4*)(sh + 4 * i);
              *(LAS f32x4*)(PL + 2 * DM + 4 * i) = gv * s1; *(LAS f32x4*)(PL + 3 * DM + 4 * i) = bv * s1 + hv; } }
      LDS_WAIT(); __syncthreads(); }
    for (int r = gw; r < MP; r += NGW) {
        asm volatile("" ::: "memory");
        const bf16* t = T + (size_t)r * DM + 8 * lane;
        v4u tw[8];
#pragma unroll
        for (int j = 0; j < 8; ++j) tw[j] = *(const GAS v4u*)(t + 512 * j);
        __builtin_amdgcn_sched_barrier(0);
        f32x4 v[16]; float s = 0.f;
#pragma unroll
        for (int j = 0; j < 8; ++j) { v[2 * j] = ubf_lo(tw[j], 0); v[2 * j + 1] = ubf_lo(tw[j], 1); }
#pragma unroll
        for (int j = 0; j < 16; ++j) s += (v[j][0] + v[j][1]) + (v[j][2] + v[j][3]);
        const float mean = wave_sum(s) * (1.f / DM); float q = 0.f;
#pragma unroll
        for (int j = 0; j < 16; ++j) { v[j] = v[j] - mean; q += (v[j][0] * v[j][0] + v[j][1] * v[j][1]) + (v[j][2] * v[j][2] + v[j][3] * v[j][3]); }
        const float rstd = 1.0f / sqrtf(wave_sum(q) * (1.f / DM) + LN_EPS);
#pragma unroll
        for (int j = 0; j < 8; ++j) { const int c = 8 * lane + 512 * j; const f32x4 n0 = v[2 * j] * rstd, n1 = v[2 * j + 1] * rstd;
            const f32x4 y0 = n0 * *(const LAS f32x4*)(PL + c) + *(const LAS f32x4*)(PL + DM + c), y1 = n1 * *(const LAS f32x4*)(PL + c + 4) + *(const LAS f32x4*)(PL + DM + c + 4);
            if (OUT_F32) { float* xo = (float*)Xout + (size_t)r * DM + c; *(f32x4*)xo = y0; *(f32x4*)(xo + 4) = y1; }
            else *(GAS v4u*)((bf16*)Xout + (size_t)r * DM + c) = pack8(y0, y1);
            if (HAS_H) { const f32x4 h0 = n0 * *(const LAS f32x4*)(PL + 2 * DM + c) + *(const LAS f32x4*)(PL + 3 * DM + c), h1 = n1 * *(const LAS f32x4*)(PL + 2 * DM + c + 4) + *(const LAS f32x4*)(PL + 3 * DM + c + 4);
                *(GAS v4u*)(H + (size_t)r * DM + c) = pack8(h0, h1); }
            if (j & 1) __builtin_amdgcn_sched_barrier(0); }
    }
    __syncthreads();
}
__device__ __forceinline__ void mixer_rows(Frame& F, const bf16* Z, const float* lng, const float* lnb, const float* qg, const float* kvg, const float* rope,
                                           bf16* VN, bf16* CQN, bf16* LAT, bf16* KALL, float* out, const float* KRS) {
    const int gw = F.vcu * NWAVES + F.wave, NGW = F.G * NWAVES, lane = F.lane;
    LAS float* PL = (LAS float*)(F.lds + RING_OFF + 1024);
    for (int i = F.tid; i < 5632 / 4; i += NWAVES * 64) { const int c = 4 * i;
        const float* src = c < 2048 ? lng + c : c < 4096 ? lnb + (c - 2048) : c < 5120 ? qg + (c - 4096) : kvg + (c - 5120);
        *(LAS f32x4*)(PL + c) = *(const f32x4*)src; }
    LDS_WAIT(); __syncthreads();
    for (int r = gw; r < M; r += NGW) {
        asm volatile("" ::: "memory");
        const bf16* z = Z + (size_t)r * 3584 + 8 * lane;
        const bool smp = r >= MP; const int rs = r - MP;
        v4u zw[7]; float kp[8];
#pragma unroll
        for (int j = 0; j < 7; ++j) zw[j] = *(const GAS v4u*)(z + 512 * j);
#pragma unroll
        for (int p = 0; p < 8; ++p) kp[p] = KRS[((size_t)p * M + r) * 64 + lane];
        const int i32 = lane & 31; const float rc = rope[(size_t)r_pos(r) * 64 + i32], rsn = rope[(size_t)r_pos(r) * 64 + 32 + i32];
        __builtin_amdgcn_sched_barrier(0);
        f32x4 v[8], cq[4], ck[2];
#pragma unroll
        for (int j = 0; j < 4; ++j) { v[2 * j] = ubf_lo(zw[j], 0); v[2 * j + 1] = ubf_lo(zw[j], 1); }
#pragma unroll
        for (int j = 0; j < 2; ++j) { cq[2 * j] = ubf_lo(zw[4 + j], 0); cq[2 * j + 1] = ubf_lo(zw[4 + j], 1); }
        ck[0] = ubf_lo(zw[6], 0); ck[1] = ubf_lo(zw[6], 1);
        float s = 0.f, q1 = 0.f, q2 = 0.f;
#pragma unroll
        for (int j = 0; j < 8; ++j) s += (v[j][0] + v[j][1]) + (v[j][2] + v[j][3]);
#pragma unroll
        for (int j = 0; j < 4; ++j) q1 += (cq[j][0] * cq[j][0] + cq[j][1] * cq[j][1]) + (cq[j][2] * cq[j][2] + cq[j][3] * cq[j][3]);
#pragma unroll
        for (int j = 0; j < 2; ++j) q2 += (ck[j][0] * ck[j][0] + ck[j][1] * ck[j][1]) + (ck[j][2] * ck[j][2] + ck[j][3] * ck[j][3]);
        s = wave_sum(s); q1 = wave_sum(q1); q2 = wave_sum(q2);
        const float mean = s * (1.f / GW); float q = 0.f;
#pragma unroll
        for (int j = 0; j < 8; ++j) { v[j] = v[j] - mean; q += (v[j][0] * v[j][0] + v[j][1] * v[j][1]) + (v[j][2] * v[j][2] + v[j][3] * v[j][3]); }
        const float rstd = 1.0f / sqrtf(wave_sum(q) * (1.f / GW) + LN_EPS);
        const float rq = 1.0f / sqrtf(q1 * (1.f / QR) + RMS_EPS), rk = 1.0f / sqrtf(q2 * (1.f / KVR) + RMS_EPS);
#pragma unroll
        for (int j = 0; j < 4; ++j) { const int c = 8 * lane + 512 * j;
            const f32x4 y0 = v[2 * j] * rstd * *(const LAS f32x4*)(PL + c) + *(const LAS f32x4*)(PL + 2048 + c), y1 = v[2 * j + 1] * rstd * *(const LAS f32x4*)(PL + c + 4) + *(const LAS f32x4*)(PL + 2048 + c + 4);
            *(GAS v4u*)(VN + (size_t)r * GW + c) = pack8(y0, y1);
            if (smp) { float* vo = out + O_VS + (size_t)rs * GW + c; *(f32x4*)vo = y0; *(f32x4*)(vo + 4) = y1; } }
#pragma unroll
        for (int j = 0; j < 2; ++j) { const int c = 8 * lane + 512 * j;
            const f32x4 y0 = cq[2 * j] * rq * *(const LAS f32x4*)(PL + 4096 + c), y1 = cq[2 * j + 1] * rq * *(const LAS f32x4*)(PL + 4096 + c + 4);
            *(GAS v4u*)(CQN + (size_t)r * QR + c) = pack8(y0, y1); }
        const size_t krow = (size_t)r_keyrow(r);
        { const int c = 8 * lane; float* lo = (smp ? out + O_LATS + (size_t)rs * KVR : out + O_LATP + (size_t)r * KVR) + c;
          const f32x4 y0 = ck[0] * rk * *(const LAS f32x4*)(PL + 5120 + c), y1 = ck[1] * rk * *(const LAS f32x4*)(PL + 5120 + c + 4);
          *(f32x4*)lo = y0; *(f32x4*)(lo + 4) = y1;
          *(GAS v4u*)(LAT + krow * KVR + c) = pack8(y0, y1); }
        { float x = ((kp[0] + kp[1]) + (kp[2] + kp[3])) + ((kp[4] + kp[5]) + (kp[6] + kp[7]));
          const float xo = __shfl_xor(x, 32);
          const float y = lane < 32 ? x * rc - xo * rsn : x * rc + xo * rsn;
          float* ko = smp ? out + O_KRS + (size_t)rs * 64 : out + O_KRP + (size_t)r * 64;
          ko[lane] = y;
          krope_store16(KALL + krow * QW, y, lane); }
    }
    __syncthreads();
}

typedef float f32x16 __attribute__((ext_vector_type(16)));
__device__ __forceinline__ int crow(int r, int hi) { return (r & 3) + 8 * (r >> 2) + 4 * hi; }
constexpr int GT_STRIDE = 272;
__device__ __forceinline__ void gate_unit(Frame& F, int r0, int L, int g, const bf16* VN, const bf16* U, const float* ws, const float* bs, bf16* MIX) {
    LAS unsigned char* vT = F.lds + RING_OFF;
    const int tid = F.tid, lane = F.lane, w = F.wave, r32 = lane & 31, hi = lane >> 5;
    const int mt = w >> 1; const bool act = 32 * mt < L;
    bf16x8 af[8];
    pg8::u32x2 uu[2][4];
    { const bf16* urow = U + (size_t)(r0 + (act ? 32 * mt + r32 : 0)) * GW + g * 128 + 4 * hi;
#pragma unroll
      for (int nn = 0; nn < 2; ++nn)
#pragma unroll
          for (int g4 = 0; g4 < 4; ++g4) uu[nn][g4] = *(const GAS pg8::u32x2*)(urow + 32 * (2 * (w & 1) + nn) + 8 * g4); }
    { const int t = 32 * mt + r32; const float* wrow = ws + (size_t)g * 128 * 128 + (size_t)t * 128;
      f32x4 wl[8][2];
#pragma unroll
      for (int ks = 0; ks < 8; ++ks) { const int s0 = (act && ks < 2 * mt + 2) ? 16 * ks + 8 * hi : 8 * hi;
          wl[ks][0] = *(const f32x4*)(wrow + s0); wl[ks][1] = *(const f32x4*)(wrow + s0 + 4); }
      __builtin_amdgcn_sched_barrier(0);
#pragma unroll
      for (int ks = 0; ks < 8; ++ks) {
          if (act && ks < 2 * mt + 2) { const int s0 = 16 * ks + 8 * hi;
              const f32x4 a = wl[ks][0], c = wl[ks][1];
              float e[8] = {a[0], a[1], a[2], a[3], c[0], c[1], c[2], c[3]};
#pragma unroll
              for (int j = 0; j < 8; ++j) if (s0 + j > t) e[j] = 0.f;
              v4u aw; aw.x = pk2(e[0], e[1]); aw.y = pk2(e[2], e[3]); aw.z = pk2(e[4], e[5]); aw.w = pk2(e[6], e[7]);
              af[ks] = __builtin_bit_cast(bf16x8, aw); }
          else af[ks] = bf16x8{};
      } }
    for (int id = tid; id < L * 16; id += NWAVES * 64) { const int s = id >> 4, cc = id & 15;
        const v4u d = *(const GAS v4u*)(VN + (size_t)(r0 + s) * GW + g * 128 + cc * 8);
        LAS unsigned short* dst = (LAS unsigned short*)(vT + (cc * 8) * GT_STRIDE + s * 2);
        dst[0 * (GT_STRIDE / 2)] = (unsigned short)(d.x & 0xffff); dst[1 * (GT_STRIDE / 2)] = (unsigned short)(d.x >> 16);
        dst[2 * (GT_STRIDE / 2)] = (unsigned short)(d.y & 0xffff); dst[3 * (GT_STRIDE / 2)] = (unsigned short)(d.y >> 16);
        dst[4 * (GT_STRIDE / 2)] = (unsigned short)(d.z & 0xffff); dst[5 * (GT_STRIDE / 2)] = (unsigned short)(d.z >> 16);
        dst[6 * (GT_STRIDE / 2)] = (unsigned short)(d.w & 0xffff); dst[7 * (GT_STRIDE / 2)] = (unsigned short)(d.w >> 16); }
    LDS_WAIT(); __syncthreads();
    if (act) {
        f32x16 acc[2]; acc[0] = f32x16{}; acc[1] = f32x16{};
        bf16x8 bq[8][2];
#pragma unroll
        for (int ks = 0; ks < 8; ++ks)
#pragma unroll
            for (int nn = 0; nn < 2; ++nn) { const int s0 = ks < 2 * mt + 2 ? 16 * ks + 8 * hi : 8 * hi, c0 = 32 * (2 * (w & 1) + nn) + r32;
                bq[ks][nn] = *(const LAS bf16x8*)(vT + c0 * GT_STRIDE + s0 * 2); }
        __builtin_amdgcn_sched_barrier(0);
#pragma unroll
        for (int ks = 0; ks < 8; ++ks) {
            if (ks < 2 * mt + 2) {
#pragma unroll
                for (int nn = 0; nn < 2; ++nn) acc[nn] = __builtin_amdgcn_mfma_f32_32x32x16_bf16(bq[ks][nn], af[ks], acc[nn], 0, 0, 0);
            }
        }
        const int tt = 32 * mt + r32; const float bias = bs[g * 128 + tt];
        bf16* mrow = MIX + (size_t)(r0 + tt) * DM + g * 128 + 4 * hi;
#pragma unroll
        for (int nn = 0; nn < 2; ++nn)
#pragma unroll
            for (int g4 = 0; g4 < 4; ++g4) { const int co = 32 * (2 * (w & 1) + nn) + 8 * g4;
                const pg8::u32x2 u2 = uu[nn][g4];
                const float u0 = __builtin_bit_cast(float, u2.x << 16), u1 = __builtin_bit_cast(float, u2.x & 0xffff0000u), u2f = __builtin_bit_cast(float, u2.y << 16), u3 = __builtin_bit_cast(float, u2.y & 0xffff0000u);
                pg8::u32x2 o; o.x = pk2(u0 * (acc[nn][4 * g4] + bias), u1 * (acc[nn][4 * g4 + 1] + bias)); o.y = pk2(u2f * (acc[nn][4 * g4 + 2] + bias), u3 * (acc[nn][4 * g4 + 3] + bias));
                *(GAS pg8::u32x2*)(mrow + co) = o; }
    }
    __syncthreads();
}

constexpr int AK_STRIDE = 400, AV_STRIDE = 144, AK_BYTES = 64 * AK_STRIDE, AV_BYTES = 128 * AV_STRIDE, ABUF = AK_BYTES + AV_BYTES;
constexpr float ATT_THR = 8.0f;
__device__ __forceinline__ void attn_unit(Frame& F, const bf16* Qb, const bf16* Kb, const bf16* Vt, int vstride, bf16* Ob, int T_max, int my_nt) {
    const int tid = F.tid, lane = F.lane, w = F.wave, r32 = lane & 31, hi = lane >> 5;
    LAS unsigned char* base = F.lds + RING_OFF;
    const int kg = (tid >> 3) * QW + (tid & 7) * 8, kl = (tid >> 3) * AK_STRIDE + (tid & 7) * 16;
    const int vg = (tid >> 2) * vstride + (tid & 3) * 8, vl = AK_BYTES + (tid >> 2) * AV_STRIDE + (tid & 3) * 16;
    v4u kreg[3], vreg[2];
#define A_LOAD(t) do { _Pragma("unroll") for (int i_ = 0; i_ < 3; ++i_) kreg[i_] = *(const GAS v4u*)(Kb + (size_t)(t) * 64 * QW + kg + 64 * i_); \
                       _Pragma("unroll") for (int i_ = 0; i_ < 2; ++i_) vreg[i_] = *(const GAS v4u*)(Vt + (size_t)(t) * 64 + vg + 32 * i_); } while (0)
#define A_WRITE(buf) do { _Pragma("unroll") for (int i_ = 0; i_ < 3; ++i_) *(LAS v4u*)(base + (buf) * ABUF + kl + 128 * i_) = kreg[i_]; \
                          _Pragma("unroll") for (int i_ = 0; i_ < 2; ++i_) *(LAS v4u*)(base + (buf) * ABUF + vl + 64 * i_) = vreg[i_]; } while (0)
    A_LOAD(0);
    bf16x8 qf[12];
    if (my_nt > 0) {
#pragma unroll
        for (int d0 = 0; d0 < 12; ++d0) qf[d0] = *(const GAS bf16x8*)(Qb + (size_t)(32 * w + r32) * QW + 16 * d0 + 8 * hi);
    } else {
#pragma unroll
        for (int d0 = 0; d0 < 12; ++d0) qf[d0] = bf16x8{};
    }
    A_WRITE(0);
    LDS_WAIT(); __syncthreads();
    f32x16 o[4]; o[0] = f32x16{}; o[1] = f32x16{}; o[2] = f32x16{}; o[3] = f32x16{};
    float m = -1e30f, lsum = 0.f;
    const int koff = r32 * AK_STRIDE + hi * 16, voff = AK_BYTES + r32 * AV_STRIDE + hi * 16;
    for (int t = 0; t < T_max; ++t) {
        const bool more = t + 1 < T_max;
        if (more) A_LOAD(t + 1);
        if (t < my_nt) {
            LAS unsigned char* kb = base + (t & 1) * ABUF + koff; LAS unsigned char* vb = base + (t & 1) * ABUF + voff;
            f32x16 p0 = f32x16{}, p1 = f32x16{};
            bf16x8 fa[4], fb[4];
#define A_KLD(dst, bt) do { _Pragma("unroll") for (int j_ = 0; j_ < 2; ++j_) { dst[2 * j_] = *(const LAS bf16x8*)(kb + (2 * (bt) + j_) * 32); dst[2 * j_ + 1] = *(const LAS bf16x8*)(kb + 32 * AK_STRIDE + (2 * (bt) + j_) * 32); } } while (0)
#define A_KMM(src, bt) do { _Pragma("unroll") for (int j_ = 0; j_ < 2; ++j_) { p0 = __builtin_amdgcn_mfma_f32_32x32x16_bf16(src[2 * j_], qf[2 * (bt) + j_], p0, 0, 0, 0); \
                                                                     p1 = __builtin_amdgcn_mfma_f32_32x32x16_bf16(src[2 * j_ + 1], qf[2 * (bt) + j_], p1, 0, 0, 0); } } while (0)
#define A_FENCE() __builtin_amdgcn_sched_barrier(0)
            A_KLD(fa, 0); A_FENCE();
            A_KLD(fb, 1); A_FENCE(); A_KMM(fa, 0); A_FENCE();
            A_KLD(fa, 2); A_FENCE(); A_KMM(fb, 1); A_FENCE();
            A_KLD(fb, 3); A_FENCE(); A_KMM(fa, 2); A_FENCE();
            A_KLD(fa, 4); A_FENCE(); A_KMM(fb, 3); A_FENCE();
            A_KLD(fb, 5); A_FENCE(); A_KMM(fa, 4); A_FENCE();
#define A_VLD(dst, d0) do { _Pragma("unroll") for (int s_ = 0; s_ < 4; ++s_) dst[s_] = *(const LAS bf16x8*)(vb + (d0) * 32 * AV_STRIDE + s_ * 32); } while (0)
            A_VLD(fa, 0); A_FENCE();
            A_KMM(fb, 5); A_FENCE();
            float mx;
            { float t[12];
              asm volatile("s_nop 15\n\ts_nop 3" : "+v"(p0), "+v"(p1));
#define A_MAX3(d, a, b, c) asm("v_max3_f32 %0, %1, %2, %3" : "=v"(d) : "v"(a), "v"(b), "v"(c))
#pragma unroll
              for (int i = 0; i < 5; ++i) { A_MAX3(t[i], p0[3 * i], p0[3 * i + 1], p0[3 * i + 2]); A_MAX3(t[5 + i], p1[3 * i], p1[3 * i + 1], p1[3 * i + 2]); }
              t[10] = p0[15]; t[11] = p1[15];
              float u0, u1, u2, u3, w0;
              A_MAX3(u0, t[0], t[1], t[2]); A_MAX3(u1, t[3], t[4], t[5]); A_MAX3(u2, t[6], t[7], t[8]); A_MAX3(u3, t[9], t[10], t[11]);
              A_MAX3(w0, u0, u1, u2); A_MAX3(mx, w0, u3, u3);
#undef A_MAX3
            }
            mx = fmaxf(mx, __shfl_xor(mx, 32));
            if (!__all(mx - m <= ATT_THR)) {
                const float mn = fmaxf(m, mx), al = __builtin_amdgcn_exp2f(m - mn); m = mn; lsum *= al;
#pragma unroll
                for (int d0 = 0; d0 < 4; ++d0) o[d0] = o[d0] * al;
            }
            float ps0 = 0.f, ps1 = 0.f, ps2 = 0.f, ps3 = 0.f;
#pragma unroll
            for (int r = 0; r < 16; ++r) { p0[r] = __builtin_amdgcn_exp2f(p0[r] - m); p1[r] = __builtin_amdgcn_exp2f(p1[r] - m); }
#pragma unroll
            for (int r = 0; r < 16; r += 2) { ps0 += p0[r]; ps1 += p0[r + 1]; ps2 += p1[r]; ps3 += p1[r + 1]; }
            lsum += (ps0 + ps1) + (ps2 + ps3);
            bf16x8 pf[4];
            { v4u x;
              x.x = pg8::cvt_pk_bf16(p0[0], p0[1]); x.y = pg8::cvt_pk_bf16(p0[2], p0[3]); x.z = pg8::cvt_pk_bf16(p0[4], p0[5]); x.w = pg8::cvt_pk_bf16(p0[6], p0[7]); pf[0] = __builtin_bit_cast(bf16x8, x);
              x.x = pg8::cvt_pk_bf16(p0[8], p0[9]); x.y = pg8::cvt_pk_bf16(p0[10], p0[11]); x.z = pg8::cvt_pk_bf16(p0[12], p0[13]); x.w = pg8::cvt_pk_bf16(p0[14], p0[15]); pf[1] = __builtin_bit_cast(bf16x8, x);
              x.x = pg8::cvt_pk_bf16(p1[0], p1[1]); x.y = pg8::cvt_pk_bf16(p1[2], p1[3]); x.z = pg8::cvt_pk_bf16(p1[4], p1[5]); x.w = pg8::cvt_pk_bf16(p1[6], p1[7]); pf[2] = __builtin_bit_cast(bf16x8, x);
              x.x = pg8::cvt_pk_bf16(p1[8], p1[9]); x.y = pg8::cvt_pk_bf16(p1[10], p1[11]); x.z = pg8::cvt_pk_bf16(p1[12], p1[13]); x.w = pg8::cvt_pk_bf16(p1[14], p1[15]); pf[3] = __builtin_bit_cast(bf16x8, x); }
#define A_VMM(src, d0) do { _Pragma("unroll") for (int s_ = 0; s_ < 4; ++s_) o[d0] = __builtin_amdgcn_mfma_f32_32x32x16_bf16(src[s_], pf[s_], o[d0], 0, 0, 0); } while (0)
            A_FENCE();
            A_VLD(fb, 1); A_FENCE(); A_VMM(fa, 0); A_FENCE();
            A_VLD(fa, 2); A_FENCE(); A_VMM(fb, 1); A_FENCE();
            A_VLD(fb, 3); A_FENCE(); A_VMM(fa, 2); A_FENCE();
            A_VMM(fb, 3); A_FENCE();
#undef A_KLD
#undef A_KMM
#undef A_VLD
#undef A_VMM
#undef A_FENCE
        }
        if (more) A_WRITE((t + 1) & 1);
        LDS_WAIT(); __syncthreads();
    }
    if (my_nt > 0) {
        const float lt = lsum + __shfl_xor(lsum, 32), inv = 1.0f / lt;
        bf16* orow = Ob + (size_t)(32 * w + r32) * DM + 4 * hi;
#pragma unroll
        for (int d0 = 0; d0 < 4; ++d0)
#pragma unroll
            for (int g4 = 0; g4 < 4; ++g4) {
                pg8::u32x2 wv; wv.x = pg8::cvt_pk_bf16(o[d0][4 * g4] * inv, o[d0][4 * g4 + 1] * inv); wv.y = pg8::cvt_pk_bf16(o[d0][4 * g4 + 2] * inv, o[d0][4 * g4 + 3] * inv);
                *(GAS pg8::u32x2*)(orow + 32 * d0 + 8 * g4) = wv;
            }
    }
#undef A_LOAD
#undef A_WRITE
}

struct Args { const float* in[28]; float* out; unsigned char* ws; int ph_lo, ph_hi; };
__global__ void __launch_bounds__(NWAVES * 64, 2) mega_fwd(Args args) {
    extern __shared__ __attribute__((aligned(16))) unsigned char lds[];
    Frame F;
    F.lds = (LAS unsigned char*)lds;
    F.MISC = (volatile LAS unsigned*)(F.lds + MISC_OFF);
    F.wave = __builtin_amdgcn_readfirstlane((int)threadIdx.x >> 6);
#define FRESH_IDS() do { F.lane = fresh_lane(); F.tid = F.wave * 64 + F.lane; } while (0)
    FRESH_IDS();
    F.G = gridDim.x; { const int bx = blockIdx.x; F.vcu = (F.G % 8 == 0) ? (bx % 8) * (F.G / 8) + bx / 8 : bx; }
    unsigned char* ws = args.ws;
    F.ctl = (gu32*)(ws + WS_CTL);
    for (int u = F.tid; u < (LDS_BYTES - LDSCTL_OFF) / 4; u += NWAVES * 64) ((LAS unsigned*)(F.lds + LDSCTL_OFF))[u] = 0u;
    __syncthreads();
    XcdBarrier bar; bar.bar = (unsigned*)(F.ctl + CW_BAR); bar.x = 0; bar.st = nullptr; bar.w0 = 0;
    if (!MK_PER_PHASE) bar = xcd_barrier_post((unsigned*)(F.ctl + CW_BAR), F.MISC + 8, F.wave);
#define GRID_BAR() do { if (!MK_PER_PHASE) xcd_barrier(bar); } while (0)
    const int lo = args.ph_lo, hi = args.ph_hi;
#define IN(k) (lo <= (k) && (k) < hi)
#define BOTH(k) (IN(k) && IN((k) + 1))

    const float* x_p = args.in[0]; const float* x_s = args.in[1];
    float* mod = (float*)(ws + WS_MOD); float* rope = (float*)(ws + WS_ROPE);
    bf16* WGU1 = (bf16*)(ws + WS_WGU1); bf16* WD1 = (bf16*)(ws + WS_WD1); bf16* WGU2 = (bf16*)(ws + WS_WGU2); bf16* WD2 = (bf16*)(ws + WS_WD2);
    bf16* WIN = (bf16*)(ws + WS_WIN); bf16* WUQ = (bf16*)(ws + WS_WUQ); bf16* WUK = (bf16*)(ws + WS_WUK); bf16* WUV = (bf16*)(ws + WS_WUV); bf16* WOUT = (bf16*)(ws + WS_WOUT);
    bf16* H = (bf16*)(ws + WS_H); bf16* ACT = (bf16*)(ws + WS_ACT); bf16* T = (bf16*)(ws + WS_T); bf16* X = (bf16*)(ws + WS_X);
    bf16* U = (bf16*)(ws + WS_U); bf16* Z = (bf16*)(ws + WS_Z); bf16* VN = (bf16*)(ws + WS_VN); bf16* CQN = (bf16*)(ws + WS_CQN); bf16* LAT = (bf16*)(ws + WS_LAT);
    bf16* Q = (bf16*)(ws + WS_Q); bf16* KALL = (bf16*)(ws + WS_KALL); bf16* VTP = (bf16*)(ws + WS_VTP); bf16* VTS = (bf16*)(ws + WS_VTS); bf16* MIX = (bf16*)(ws + WS_MIX); float* SL = (float*)(ws + WS_SL); float* KRS = (float*)(ws + WS_KRS);

    if (IN(0)) { FRESH_IDS();
        mod_phase(F, args.in[4], args.in[5], args.in[6], args.in[7], mod);
        rope_phase(F, rope);
        cache_phase(F, args.in[2], args.in[3], LAT, KALL);
        int it0 = 0;
        transpose_matrix<1>(F, args.in[8], DM, 2 * DFF, WGU1, it0);
        if (BOTH(0)) GRID_BAR();
    }
    if (IN(1)) { FRESH_IDS(); modulate_rows(F, x_p, x_s, mod, 0, H); if (BOTH(1)) GRID_BAR(); }
    if (IN(2)) { FRESH_IDS();
        const int GD = (F.G == 256) ? 244 : F.G;
        if ((int)blockIdx.x < GD) {
            pg8::Gemm g{H, WGU1, M, 2 * DFF, DM}; pg8::StaticOrder S; S.init(M, 2 * DFF, GD, (int)blockIdx.x, DM);
            pg8::EpiSwiglu E{ACT, DFF};
            pg8::gemm_phase<pg8::EpiSwiglu, pg8::StaticOrder, true, true>(F.lds + RING_OFF, g, S, E, F.tid);
        }
        conv_pull(F, 0, args.in, ws);
        if (BOTH(2)) GRID_BAR();
    }
    if (IN(3)) { FRESH_IDS();
        pg8::Gemm g{ACT, WD1, M, DM, DFF}; pg8::SplitOrder S; S.init(MP, DM, F.G, (int)blockIdx.x, DFF, 8, 32, 32, 16, 0);
        pg8::EpiResid<false> E{x_p, mod + 2 * DM, T, 0.5f, SL};
        pg8::gemm_phase<pg8::EpiResid<false>, pg8::SplitOrder, true, true>(F.lds + RING_OFF, g, S, E, F.tid);
        if (BOTH(3)) GRID_BAR();
    }
    if (IN(4)) { FRESH_IDS(); ln_rows<true, true, false>(F, T, args.in[10], args.in[11], X, mod, 3, H, SL, x_s, mod + 2 * DM, 0.5f); if (BOTH(4)) GRID_BAR(); }
    if (IN(5)) { FRESH_IDS();
        pg8::Gemm g{H, WIN, M, 5888, DM}; pg8::SplitOrder S; S.init(M, 5632, F.G, (int)blockIdx.x, DM, 8, 34, 0, 1, 22);
        pg8::EpiWin E{U, Z, KRS};
        pg8::gemm_phase<pg8::EpiWin, pg8::SplitOrder, true, true>(F.lds + RING_OFF, g, S, E, F.tid);
        if (BOTH(5)) GRID_BAR();
    }
    if (IN(6)) { FRESH_IDS(); mixer_rows(F, Z, args.in[13], args.in[14], args.in[17], args.in[19], rope, VN, CQN, LAT, KALL, args.out, KRS); if (BOTH(6)) GRID_BAR(); }
    if (IN(7)) { FRESH_IDS();
        { pg8::Gemm g{CQN, WUQ, M, QW, QR}; pg8::StaticOrder S; S.init(M, QW, F.G, (int)blockIdx.x, QR);
          pg8::EpiHeads E{Q, QSCALE, 8, rope};
          pg8::gemm_phase<pg8::EpiHeads, pg8::StaticOrder, true, true>(F.lds + RING_OFF, g, S, E, F.tid); }
        { pg8::Gemm g{LAT, WUK, LATROWS, 2048, KVR}; pg8::StaticOrder S; S.init(LATROWS, 2048, F.G, (int)blockIdx.x, KVR);
          pg8::EpiHeads E{KALL, 1.0f, 8, rope};
          pg8::gemm_phase<pg8::EpiHeads, pg8::StaticOrder, true, true>(F.lds + RING_OFF, g, S, E, F.tid); }
        { pg8::Gemm g{WUV, LAT, 2048, LATROWS, KVR}; pg8::StaticOrder S; S.init(2048, LATROWS, F.G, (int)blockIdx.x, KVR);
          pg8::EpiVt E{VTP, VTS};
          pg8::gemm_phase<pg8::EpiVt, pg8::StaticOrder, true, true>(F.lds + RING_OFF, g, S, E, F.tid); }
        for (int n = 0; n < GATE_P7 && (int)blockIdx.x >= 16; ++n) {
            if (F.tid == 0) F.MISC[0] = __hip_atomic_fetch_add(F.ctl + CW_GATEQ, 1u, __ATOMIC_RELAXED, __HIP_MEMORY_SCOPE_AGENT);
            LDS_WAIT(); __syncthreads();
            const int u = __builtin_amdgcn_readfirstlane((int)F.MISC[0]);
            if (u >= 1152) break;
            if (u < 1024) gate_unit(F, 128 * (u >> 4), 128, u & 15, VN, U, args.in[15], args.in[16], MIX);
            else { const int v = u - 1024; gate_unit(F, MP + 64 * (v >> 4), 64, v & 15, VN, U, args.in[15], args.in[16], MIX); }
        }
        if (BOTH(7)) GRID_BAR();
    }
    if (IN(8)) { FRESH_IDS();
        const int xme = (int)xb_xcc_id() & 7;
        for (int sq = 0; sq < 8; ++sq) { const int xq = (xme + sq) & 7;
        for (;;) {
            if (F.tid == 0) F.MISC[0] = __hip_atomic_fetch_add(F.ctl + 2048 + 64 * xq, 1u, __ATOMIC_RELAXED, __HIP_MEMORY_SCOPE_AGENT);
            LDS_WAIT(); __syncthreads();
            const int qi = __builtin_amdgcn_readfirstlane((int)F.MISC[0]);
            __syncthreads();
            if (qi >= 80) break;
            const int hq = xq + 8 * (qi & 1), idx = qi < 48 ? 16 * (qi >> 1) + hq : qi < 64 ? 384 + 16 * ((qi - 48) >> 1) + hq : 128 + 16 * (24 + ((qi - 64) >> 1)) + hq;
            {
                const bf16 *Qb, *Kb, *Vt; bf16* Ob; int vstride, T_max, my_nt;
                if (idx >= 384 && idx < 512) { const int u = idx - 384, b = u >> 4, h = u & 15;
                    Qb = Q + (size_t)(MP + 64 * b) * QW + h * 192; Kb = KALL + (size_t)(MP + b * KS) * QW + h * 192; Vt = VTS + ((size_t)b * 2048 + h * 128) * KS; vstride = KS;
                    Ob = MIX + (size_t)(MP + 64 * b) * DM + 2048 + h * 128; T_max = 33; my_nt = F.wave < 2 ? 33 : 0; }
                else { const int u = idx < 384 ? idx : idx - 128, qb = 31 - (u >> 4), h = u & 15;
                    Qb = Q + (size_t)(256 * qb) * QW + h * 192; Kb = KALL + h * 192; Vt = VTP + (size_t)(h * 128) * MP; vstride = MP;
                    Ob = MIX + (size_t)(256 * qb) * DM + 2048 + h * 128; T_max = 4 * qb + 4; my_nt = 4 * qb + (F.wave >> 1) + 1; }
                attn_unit(F, Qb, Kb, Vt, vstride, Ob, T_max, my_nt);
            }
        }
        }
        for (;;) {
            if (F.tid == 0) F.MISC[0] = __hip_atomic_fetch_add(F.ctl + CW_GATEQ, 1u, __ATOMIC_RELAXED, __HIP_MEMORY_SCOPE_AGENT);
            LDS_WAIT(); __syncthreads();
            const int u = __builtin_amdgcn_readfirstlane((int)F.MISC[0]);
            if (u >= 1152) break;
            if (u < 1024) gate_unit(F, 128 * (u >> 4), 128, u & 15, VN, U, args.in[15], args.in[16], MIX);
            else { const int v = u - 1024; gate_unit(F, MP + 64 * (v >> 4), 64, v & 15, VN, U, args.in[15], args.in[16], MIX); }
        }
        if (BOTH(8)) GRID_BAR();
    }
    if (IN(9)) { FRESH_IDS();
        pg8::Gemm g{MIX, WOUT, M, DM, DM}; pg8::SplitOrder S; S.init(MP, DM, F.G, (int)blockIdx.x, DM, 8, 32, 32, 16, 0);
        pg8::EpiResid<true> E{X, mod + 5 * DM, T, 1.0f, SL};
        pg8::gemm_phase<pg8::EpiResid<true>, pg8::SplitOrder, true, true>(F.lds + RING_OFF, g, S, E, F.tid);
        if (BOTH(9)) GRID_BAR();
    }
    if (IN(10)) { FRESH_IDS(); ln_rows<true, false, false>(F, T, args.in[22], args.in[23], X, mod, 6, H, SL, X + (size_t)MP * DM, mod + 5 * DM, 1.0f); if (BOTH(10)) GRID_BAR(); }
    if (IN(11)) { FRESH_IDS();
        const int GD = (F.G == 256) ? 244 : F.G;
        if ((int)blockIdx.x < GD) {
            pg8::Gemm g{H, WGU2, M, 2 * DFF, DM}; pg8::StaticOrder S; S.init(M, 2 * DFF, GD, (int)blockIdx.x, DM);
            pg8::EpiSwiglu E{ACT, DFF};
            pg8::gemm_phase<pg8::EpiSwiglu, pg8::StaticOrder, true, true>(F.lds + RING_OFF, g, S, E, F.tid);
        }
        conv_pull(F, 1, args.in, ws);
        if (BOTH(11)) GRID_BAR();
    }
    if (IN(12)) { FRESH_IDS();
        pg8::Gemm g{ACT, WD2, M, DM, DFF}; pg8::SplitOrder S; S.init(MP, DM, F.G, (int)blockIdx.x, DFF, 8, 32, 32, 16, 0);
        pg8::EpiResid<true> E{X, mod + 8 * DM, T, 0.5f, SL};
        pg8::gemm_phase<pg8::EpiResid<true>, pg8::SplitOrder, true, true>(F.lds + RING_OFF, g, S, E, F.tid);
        if (BOTH(12)) GRID_BAR();
    }
    if (IN(13)) { FRESH_IDS(); ln_rows<false, false, true>(F, T, args.in[26], args.in[27], args.out + O_Y, mod, 0, H, SL, X + (size_t)MP * DM, mod + 8 * DM, 0.5f); }
#undef IN
#undef BOTH
}

extern "C" void kernel_launch(void* const* d_in, const int* in_sizes, int n_in, void* d_out, int out_size, void* d_ws, size_t ws_size, hipStream_t stream) {
    static int grid = 0;
    if (grid == 0) {
        if (n_in != 28 || ws_size < WS_END) { fprintf(stderr, "kernel_launch: expected 28 inputs and >= %zu bytes of workspace; got %d, %zu\n", (size_t)WS_END, n_in, ws_size); grid = -1; return; }
        int dev = 0, cus = 0, per_cu = 0;
        if (hipGetDevice(&dev) != hipSuccess || hipDeviceGetAttribute(&cus, hipDeviceAttributeMultiprocessorCount, dev) != hipSuccess) { grid = -1; return; }
        if (hipFuncSetAttribute((const void*)mega_fwd, hipFuncAttributeMaxDynamicSharedMemorySize, LDS_BYTES) != hipSuccess) { fprintf(stderr, "kernel_launch: hipFuncSetAttribute failed\n"); grid = -1; return; }
        if (hipOccupancyMaxActiveBlocksPerMultiprocessor(&per_cu, (const void*)mega_fwd, NWAVES * 64, LDS_BYTES) != hipSuccess || per_cu < 1)
            fprintf(stderr, "kernel_launch: occupancy query reports %d blocks per CU\n", per_cu);
        (void)hipGetLastError();
        grid = cus;
    }
    if (grid < 0) return;
    if (hipMemsetAsync((char*)d_ws + WS_CTL, 0, CTL_ZERO_BYTES, stream) != hipSuccess) return;
    Args a{};
    for (int i = 0; i < 28; ++i) a.in[i] = (const float*)d_in[i];
    a.out = (float*)d_out; a.ws = (unsigned char*)d_ws;
#if MK_PER_PHASE
    for (int p = 0; p < N_PHASES; ++p) { a.ph_lo = p; a.ph_hi = p + 1; hipLaunchKernelGGL(mega_fwd, dim3(grid), dim3(NWAVES * 64), LDS_BYTES, stream, a); }
#else
    a.ph_lo = 0; a.ph_hi = N_PHASES; hipLaunchKernelGGL(mega_fwd, dim3(grid), dim3(NWAVES * 64), LDS_BYTES, stream, a);
#endif
    const hipError_t le = hipPeekAtLastError();
    if (le != hipSuccess) fprintf(stderr, "kernel_launch: launch failed: %s\n", hipGetErrorName(le));
}
```

```cpp
#include <hip/hip_runtime.h>
#include <cstdio>
#include <cstdint>
namespace pg8 {
#define PG8_LAS __attribute__((address_space(3)))
typedef unsigned short bf16_t;
typedef short bf16x8 __attribute__((ext_vector_type(8)));
typedef float f32x4 __attribute__((ext_vector_type(4)));
typedef unsigned u32x4 __attribute__((ext_vector_type(4)));
constexpr int BM = 256, BK = 64, HALF = 128, HTB = HALF * BK * 2  , STAGE_BYTES = 8 * HTB, NXCD = 8, WGM = 8;

__host__ __device__ __forceinline__ int lds_byte(int r, int c) { const int st = (r >> 4) * 2 + (c >> 5), rr = r & 15, cc = c & 31, ob = rr * 64 + cc * 2; return st * 1024 + (ob ^ (((ob >> 9) & 1) << 5)); }
__host__ __device__ __forceinline__ void stage_rc(int b, int& R, int& C) { const int st = b / 1024, sb = b % 1024, swz = sb ^ (((sb >> 9) & 1) << 5); R = (st >> 1) * 16 + swz / 64; C = (st & 1) * 32 + (swz % 64) / 2; }
__host__ __device__ __forceinline__ int perm32(int rho) { const int n = rho >> 4, i = rho & 15; return 8 * (i >> 2) + 4 * n + (i & 3); }

struct Unit { int pm, pn, k0, nk, part; };
struct Gemm { const bf16_t* A; const bf16_t* Bt; int M, N, K; };

struct StaticOrder {
    int nM, nN, nwg, G, c, nkt;
    __host__ __device__ void init(int M, int N, int G_, int c_, int K) { nM = M / BM; nN = N / BM; nwg = nM * nN; G = G_; c = c_; nkt = K / BK; }
    __host__ __device__ bool next(int i, Unit& u) const {
        const long L = (long)i * G + c; if (L >= nwg) return false;
        int wgid = (int)L; { const int q = nwg / NXCD, r = nwg % NXCD, xcd = wgid % NXCD, off = wgid / NXCD; wgid = (xcd < r ? xcd * (q + 1) : r * (q + 1) + (xcd - r) * q) + off; }
        const int nig = WGM * nN, gid = wgid / nig, fm = gid * WGM, gsz = (nM - fm) < WGM ? (nM - fm) : WGM;
        u.pm = fm + ((wgid % nig) % gsz); u.pn = (wgid % nig) / gsz; u.k0 = 0; u.nk = nkt; u.part = -1; return true;
    }
    __device__ __forceinline__ void a_ready(const Unit&) const {}
    __device__ __forceinline__ void done(const Unit&) const {}
};
struct SplitOrder {
    StaticOrder full; int S, base, extra, nsub, sp_pm0, sp_npn, sp_pn0;
    __host__ __device__ void init(int Mfull, int Nfull, int G_, int c_, int K, int S_, int ntiles_split, int pm0, int npn, int pn0) {
        full.init(Mfull, Nfull, G_, c_, K); S = S_; const int nk = K / BK; base = 2 * (nk / (2 * S)); extra = (nk - base * S) / 2; nsub = ntiles_split * S; sp_pm0 = pm0; sp_npn = npn; sp_pn0 = pn0; }
    __host__ __device__ bool next(int i, Unit& u) const {
        const int cs = (full.c - full.nwg % full.G + full.G) % full.G;
        const int ns = cs < nsub ? (nsub - cs + full.G - 1) / full.G : 0;
        if (i >= ns) return full.next(i - ns, u);
        const int j = i * full.G + cs;
        const int ti = j / S, s = j - ti * S;
        u.pm = sp_pm0 + ti / sp_npn; u.pn = sp_pn0 + ti % sp_npn; u.k0 = base * s + 2 * (s < extra ? s : extra); u.nk = base + (s < extra ? 2 : 0); u.part = s; return true;
    }
    __device__ __forceinline__ void a_ready(const Unit&) const {}
    __device__ __forceinline__ void done(const Unit&) const {}
};

typedef float f32x2c __attribute__((ext_vector_type(2))); typedef __bf16 bf16x2c __attribute__((ext_vector_type(2)));
__device__ __forceinline__ unsigned cvt_pk_bf16(float lo, float hi) { const f32x2c v = {lo, hi}; return __builtin_bit_cast(unsigned, __builtin_convertvector(v, bf16x2c)); }
typedef float f32x2 __attribute__((ext_vector_type(2)));
typedef unsigned u32x2 __attribute__((ext_vector_type(2)));
constexpr int E_MP = 8192;
constexpr int E_NMOD = 9 * 4096;
__device__ __forceinline__ int e_sidx(int r) { return r < E_MP ? 0 : 1 + ((r - E_MP) >> 6); }
__device__ __forceinline__ int e_pos(int r) { return r < E_MP ? r : 2048 + ((r - E_MP) & 63); }
__device__ __forceinline__ float silu_f(float g) { return g * __builtin_amdgcn_rcpf(1.0f + __builtin_amdgcn_exp2f(-1.4426950408889634f * g)); }

struct EpiSwiglu {
    static constexpr bool PERM = true, AFTER_DRAIN = false;
    bf16_t* O; int ldc;
    __device__ __forceinline__ void operator()(const f32x4 (&acc)[2][2][4][2], const Unit& u, int wr, int wc, int fr, int fq) const {
        const int row0 = u.pm * BM + wr * 64 + fr, col0 = u.pn * HALF + wc * 32 + 8 * fq;
#pragma unroll
        for (int ai = 0; ai < 2; ++ai)
#pragma unroll
            for (int m = 0; m < 4; ++m) {
                bf16_t* rowp = O + (size_t)(row0 + ai * HALF + m * 16) * ldc + col0;
                const f32x4 g0 = acc[ai][0][m][0], g1 = acc[ai][0][m][1], u0 = acc[ai][1][m][0], u1 = acc[ai][1][m][1];
                f32x4 e0 = g0 * -1.4426950408889634f, e1 = g1 * -1.4426950408889634f;
#pragma unroll
                for (int i = 0; i < 4; ++i) { e0[i] = __builtin_amdgcn_exp2f(e0[i]); e1[i] = __builtin_amdgcn_exp2f(e1[i]); }
                f32x4 d0 = e0 + 1.0f, d1 = e1 + 1.0f;
#pragma unroll
                for (int i = 0; i < 4; ++i) { d0[i] = __builtin_amdgcn_rcpf(d0[i]); d1[i] = __builtin_amdgcn_rcpf(d1[i]); }
                const f32x4 r0 = (g0 * u0) * d0, r1 = (g1 * u1) * d1;
                u32x4 w;
                w.x = cvt_pk_bf16(r0[0], r0[1]); w.y = cvt_pk_bf16(r0[2], r0[3]); w.z = cvt_pk_bf16(r1[0], r1[1]); w.w = cvt_pk_bf16(r1[2], r1[3]);
                *(u32x4*)rowp = w;
            }
    }
};
__device__ __forceinline__ f32x4 bf_lo4(u32x2 w) { return (f32x4){__builtin_bit_cast(float, w.x << 16), __builtin_bit_cast(float, w.x & 0xffff0000u), __builtin_bit_cast(float, w.y << 16), __builtin_bit_cast(float, w.y & 0xffff0000u)}; }
template <bool XBF> struct EpiResid {
    static constexpr bool PERM = true, AFTER_DRAIN = false;
    const void* Xin; const float* gate; bf16_t* T; float gs; float* SL;
    __device__ __forceinline__ void operator()(const f32x4 (&acc)[2][2][4][2], const Unit& u, int wr, int wc, int fr, int fq) const {
        const int row0 = u.pm * BM + wr * 64 + fr, col0 = u.pn * BM + wc * 32 + 8 * fq;
        if (u.part >= 0) {
#pragma unroll
            for (int ai = 0; ai < 2; ++ai)
#pragma unroll
                for (int m = 0; m < 4; ++m) { float* sr = SL + ((size_t)u.part * 512 + (size_t)(row0 + ai * HALF + m * 16 - E_MP)) * 4096 + col0;
#pragma unroll
                    for (int bj = 0; bj < 2; ++bj) { *(f32x4*)(sr + bj * HALF) = acc[ai][bj][m][0]; *(f32x4*)(sr + bj * HALF + 4) = acc[ai][bj][m][1]; } }
            return;
        }
        f32x4 gv[2][2];
#pragma unroll
        for (int bj = 0; bj < 2; ++bj) { gv[bj][0] = *(const f32x4*)(gate + col0 + bj * HALF) * gs; gv[bj][1] = *(const f32x4*)(gate + col0 + bj * HALF + 4) * gs; }
#pragma unroll
        for (int ai = 0; ai < 2; ++ai) {
            f32x4 xf[4][2][2]; u32x4 xb[4][2];
#pragma unroll
            for (int m = 0; m < 4; ++m) { const size_t off = (size_t)(row0 + ai * HALF + m * 16) * 4096 + col0;
#pragma unroll
                for (int bj = 0; bj < 2; ++bj) {
                    if (XBF) xb[m][bj] = *(const u32x4*)((const bf16_t*)Xin + off + bj * HALF);
                    else { xf[m][bj][0] = *(const f32x4*)((const float*)Xin + off + bj * HALF); xf[m][bj][1] = *(const f32x4*)((const float*)Xin + off + bj * HALF + 4); } } }
            __builtin_amdgcn_sched_barrier(0);
#pragma unroll
            for (int m = 0; m < 4; ++m) { const size_t off = (size_t)(row0 + ai * HALF + m * 16) * 4096 + col0;
#pragma unroll
                for (int bj = 0; bj < 2; ++bj) {
                    f32x4 x0, x1;
                    if (XBF) { x0 = bf_lo4((u32x2){xb[m][bj].x, xb[m][bj].y}); x1 = bf_lo4((u32x2){xb[m][bj].z, xb[m][bj].w}); } else { x0 = xf[m][bj][0]; x1 = xf[m][bj][1]; }
                    const f32x4 t0 = x0 * 1.189207115002721f + gv[bj][0] * acc[ai][bj][m][0], t1 = x1 * 1.189207115002721f + gv[bj][1] * acc[ai][bj][m][1];
                    u32x4 w; w.x = cvt_pk_bf16(t0[0], t0[1]); w.y = cvt_pk_bf16(t0[2], t0[3]); w.z = cvt_pk_bf16(t1[0], t1[1]); w.w = cvt_pk_bf16(t1[2], t1[3]);
                    *(u32x4*)(T + off + bj * HALF) = w;
                } }
            __builtin_amdgcn_sched_barrier(0);
        }
    }
};
struct EpiWin {
    static constexpr bool PERM = true, AFTER_DRAIN = false;
    bf16_t* U; bf16_t* Z; float* KRS;
    __device__ __forceinline__ void operator()(const f32x4 (&acc)[2][2][4][2], const Unit& u, int wr, int wc, int fr, int fq) const {
        const int row0 = u.pm * BM + wr * 64 + fr, col0 = u.pn * BM + wc * 32 + 8 * fq;
        if (u.part >= 0) {
            if (wc < 2) {
#pragma unroll
                for (int ai = 0; ai < 2; ++ai)
#pragma unroll
                    for (int m = 0; m < 4; ++m) { float* sr = KRS + ((size_t)u.part * 8704 + (size_t)(row0 + ai * HALF + m * 16)) * 64 + wc * 32 + 8 * fq;
                        *(f32x4*)sr = acc[ai][0][m][0]; *(f32x4*)(sr + 4) = acc[ai][0][m][1]; }
            }
            return;
        }
        bf16_t* base; int ld, c;
        if (u.pn < 8) { base = U; ld = 2048; c = col0; } else { base = Z; ld = 3584; c = col0 - 2048; }
#pragma unroll
        for (int ai = 0; ai < 2; ++ai)
#pragma unroll
            for (int m = 0; m < 4; ++m) { bf16_t* rowp = base + (size_t)(row0 + ai * HALF + m * 16) * ld + c;
#pragma unroll
                for (int bj = 0; bj < 2; ++bj) { const f32x4 v0 = acc[ai][bj][m][0], v1 = acc[ai][bj][m][1]; u32x4 w;
                    w.x = cvt_pk_bf16(v0[0], v0[1]); w.y = cvt_pk_bf16(v0[2], v0[3]); w.z = cvt_pk_bf16(v1[0], v1[1]); w.w = cvt_pk_bf16(v1[2], v1[3]);
                    *(u32x4*)(rowp + bj * HALF) = w; } }
    }
};
struct EpiHeads {
    static constexpr bool PERM = true, AFTER_DRAIN = false;
    bf16_t* O; float scale; int rope_tile0; const float* rope;
    __device__ __forceinline__ void operator()(const f32x4 (&acc)[2][2][4][2], const Unit& u, int wr, int wc, int fr, int fq) const {
        const int row0 = u.pm * BM + wr * 64 + fr;
        if (u.pn < rope_tile0) {
#pragma unroll
            for (int ai = 0; ai < 2; ++ai)
#pragma unroll
                for (int m = 0; m < 4; ++m) { bf16_t* rowp = O + (size_t)(row0 + ai * HALF + m * 16) * 3072 + wc * 32 + 8 * fq;
#pragma unroll
                    for (int bj = 0; bj < 2; ++bj) { const f32x4 v0 = acc[ai][bj][m][0] * scale, v1 = acc[ai][bj][m][1] * scale; u32x4 w;
                        w.x = cvt_pk_bf16(v0[0], v0[1]); w.y = cvt_pk_bf16(v0[2], v0[3]); w.z = cvt_pk_bf16(v1[0], v1[1]); w.w = cvt_pk_bf16(v1[2], v1[3]);
                        *(u32x4*)(rowp + (2 * u.pn + bj) * 192) = w; } }
        } else {
            const int head = 4 * (u.pn - rope_tile0) + wc, i0 = 8 * fq;
#pragma unroll
            for (int am = 0; am < 4; ++am) {
                const int ai = am >> 1;
                f32x4 rc[2][4];
#pragma unroll
                for (int mm = 0; mm < 2; ++mm) { const int m = 2 * (am & 1) + mm; const float* rp = rope + (size_t)e_pos(row0 + ai * HALF + m * 16) * 64 + i0;
                    rc[mm][0] = *(const f32x4*)rp; rc[mm][1] = *(const f32x4*)(rp + 4); rc[mm][2] = *(const f32x4*)(rp + 32); rc[mm][3] = *(const f32x4*)(rp + 36); }
                __builtin_amdgcn_sched_barrier(0);
#pragma unroll
                for (int mm = 0; mm < 2; ++mm) { const int m = 2 * (am & 1) + mm; const int row = row0 + ai * HALF + m * 16;
                    const f32x4 c0 = rc[mm][0], c1 = rc[mm][1], s0 = rc[mm][2], s1 = rc[mm][3];
                    const f32x4 a0 = acc[ai][0][m][0], a1 = acc[ai][0][m][1], b0 = acc[ai][1][m][0], b1 = acc[ai][1][m][1];
                    const f32x4 o10 = (a0 * c0 - b0 * s0) * scale, o11 = (a1 * c1 - b1 * s1) * scale, o20 = (b0 * c0 + a0 * s0) * scale, o21 = (b1 * c1 + a1 * s1) * scale;
                    bf16_t* rowp = O + (size_t)row * 3072 + head * 192 + 128 + i0; u32x4 w;
                    w.x = cvt_pk_bf16(o10[0], o10[1]); w.y = cvt_pk_bf16(o10[2], o10[3]); w.z = cvt_pk_bf16(o11[0], o11[1]); w.w = cvt_pk_bf16(o11[2], o11[3]); *(u32x4*)rowp = w;
                    w.x = cvt_pk_bf16(o20[0], o20[1]); w.y = cvt_pk_bf16(o20[2], o20[3]); w.z = cvt_pk_bf16(o21[0], o21[1]); w.w = cvt_pk_bf16(o21[2], o21[3]); *(u32x4*)(rowp + 32) = w; }
                __builtin_amdgcn_sched_barrier(0);
            }
        }
    }
};
struct EpiVt {
    static constexpr bool PERM = false, AFTER_DRAIN = false;
    bf16_t* VTP; bf16_t* VTS;
    __device__ __forceinline__ void operator()(const f32x4 (&acc)[2][2][4][2], const Unit& u, int wr, int wc, int fr, int fq) const {
        const int f0 = u.pm * BM + wr * 64 + fr, sw = ((fq & 1) << 1) | (fq >> 1);
#pragma unroll
        for (int bj = 0; bj < 2; ++bj)
#pragma unroll
            for (int n = 0; n < 2; ++n) {
                const int tok = u.pn * BM + bj * HALF + wc * 32 + n * 16;
                bf16_t* base; int stride;
                if (tok < E_MP) { base = VTP + tok + 4 * sw; stride = 8192; }
                else { const int t2 = tok - E_MP, b = t2 / 2112, j = t2 - b * 2112; base = VTS + (size_t)b * 2048 * 2112 + j + 4 * sw; stride = 2112; }
#pragma unroll
                for (int ai = 0; ai < 2; ++ai)
#pragma unroll
                    for (int m = 0; m < 4; ++m) { const f32x4 v = acc[ai][bj][m][n]; u32x2 w; w.x = cvt_pk_bf16(v[0], v[1]); w.y = cvt_pk_bf16(v[2], v[3]);
                        *(u32x2*)(base + (size_t)(f0 + ai * HALF + m * 16) * stride) = w; }
            }
    }
};
template <class Epi, class Sched, bool ALIGN_EPI = false, bool SP2 = false>
__device__ __forceinline__ void gemm_phase(PG8_LAS unsigned char* lds, const Gemm g, const Sched& S, const Epi& E, const int tid) {
    const int wid = __builtin_amdgcn_readfirstlane(tid >> 6), lane = tid & 63, wr = wid >> 2, wc = wid & 3, fr = lane & 15, fq = lane >> 4;
    const int K = g.K;
    unsigned voffA[2], voffB[2];
#pragma unroll
    for (int i = 0; i < 2; ++i) { int R, C; stage_rc(tid * 16 + i * 8192, R, C); const int Rb = Epi::PERM ? ((R & ~31) + perm32(R & 31)) : R;
        voffA[i] = (unsigned)(R * K + C) * 2u; voffB[i] = (unsigned)(Rb * K + C) * 2u; }
    const size_t kstep = (size_t)(BK * 2);
    const size_t hstep = (size_t)HALF * K * 2;
    const size_t tstep = 2 * hstep;
    const unsigned ldsw = (unsigned)wid * 1024u;
    const int aoff = lds_byte(wr * 64 + fr, fq * 8), boff = lds_byte(wc * 32 + fr, fq * 8);
#define PG8_SA(b, h) (((b) * 2 + (h)) * HTB)
#define PG8_SB(b, h) ((4 + (b) * 2 + (h)) * HTB)
#define PG8_STAGE(bufoff, gbase, voff) do { _Pragma("unroll") for (int _i = 0; _i < 2; ++_i) \
        __builtin_amdgcn_global_load_lds((const unsigned*)((const char*)(gbase) + (voff)[_i]), (PG8_LAS unsigned*)(lds + (bufoff) + ldsw + _i * 8192), 16, 0, 0); } while (0)
#define PG8_LDA(dst, b, h) do { _Pragma("unroll") for (int m = 0; m < 4; ++m) _Pragma("unroll") for (int k = 0; k < 2; ++k) dst[m][k] = *(const PG8_LAS bf16x8*)(lds + PG8_SA(b, h) + aoff + m * 2048 + k * 1024); } while (0)
#define PG8_LDB(dst, b, h) do { _Pragma("unroll") for (int n = 0; n < 2; ++n) _Pragma("unroll") for (int k = 0; k < 2; ++k) dst[n][k] = *(const PG8_LAS bf16x8*)(lds + PG8_SB(b, h) + boff + n * 2048 + k * 1024); } while (0)
#define PG8_MMA(ai, bj, At, Bt) do { __builtin_amdgcn_s_setprio(1); _Pragma("unroll") for (int m = 0; m < 4; ++m) _Pragma("unroll") for (int n = 0; n < 2; ++n) _Pragma("unroll") for (int k = 0; k < 2; ++k) \
        acc[ai][bj][m][n] = __builtin_amdgcn_mfma_f32_16x16x32_bf16(Bt[n][k], At[m][k], acc[ai][bj][m][n], 0, 0, 0); __builtin_amdgcn_s_setprio(0); } while (0)
#define PG8_WAIT_V(n) asm volatile("s_waitcnt vmcnt(" #n ")" ::: "memory")
#define PG8_WAIT_L(n) asm volatile("s_waitcnt lgkmcnt(" #n ")" ::: "memory")
#define PG8_BAR __builtin_amdgcn_s_barrier()
#define PG8_SCHED __builtin_amdgcn_sched_barrier(0)
    Unit cur, nxt; int ui = 0;
    if (!S.next(0, cur)) return;
    f32x4 acc[2][2][4][2];
#pragma unroll
    for (int a = 0; a < 2; ++a)
#pragma unroll
        for (int b = 0; b < 2; ++b)
#pragma unroll
            for (int m = 0; m < 4; ++m)
#pragma unroll
                for (int n = 0; n < 2; ++n) acc[a][b][m][n] = (f32x4){0.f, 0.f, 0.f, 0.f};
    bf16x8 At[4][2], B0[2][2], B1[2][2];
    const char* cA = (const char*)g.A + (size_t)cur.pm * tstep + (size_t)cur.k0 * kstep; const char* cB = (const char*)g.Bt + (size_t)cur.pn * tstep + (size_t)cur.k0 * kstep;
    S.a_ready(cur);
    if constexpr (SP2) {
        PG8_STAGE(PG8_SB(0, 0), cB, voffB); PG8_STAGE(PG8_SB(0, 1), cB + hstep, voffB); PG8_STAGE(PG8_SA(0, 0), cA, voffA); PG8_STAGE(PG8_SA(0, 1), cA + hstep, voffA);
        if (wr == 1) PG8_BAR;
        PG8_WAIT_V(2); PG8_BAR;
        PG8_STAGE(PG8_SB(1, 0), cB + kstep, voffB); PG8_STAGE(PG8_SA(1, 0), cA + kstep, voffA); PG8_STAGE(PG8_SB(1, 1), cB + hstep + kstep, voffB);
        PG8_WAIT_V(6); PG8_BAR;
    } else {
        PG8_STAGE(PG8_SB(0, 0), cB, voffB); PG8_STAGE(PG8_SA(0, 0), cA, voffA); PG8_STAGE(PG8_SB(0, 1), cB + hstep, voffB); PG8_STAGE(PG8_SA(0, 1), cA + hstep, voffA);
        if (wr == 1) PG8_BAR;
        PG8_WAIT_V(4); PG8_BAR;
        PG8_STAGE(PG8_SB(1, 0), cB + kstep, voffB); PG8_STAGE(PG8_SA(1, 0), cA + kstep, voffA); PG8_STAGE(PG8_SB(1, 1), cB + hstep + kstep, voffB);
        PG8_WAIT_V(6); PG8_BAR;
    }
    for (;;) {
        const bool has_next = S.next(ui + 1, nxt);
        const char* nA = has_next ? (const char*)g.A + (size_t)nxt.pm * tstep + (size_t)nxt.k0 * kstep : cA; const char* nB = has_next ? (const char*)g.Bt + (size_t)nxt.pn * tstep + (size_t)nxt.k0 * kstep : cB;
        const int nt = cur.nk;
        for (int t = 0; t < nt; t += 2) {
            const bool last = (t == nt - 2);
            const char* a1 = cA + (size_t)(t + 1) * kstep;
            const char* a2 = last ? nA : cA + (size_t)(t + 2) * kstep; const char* b2 = last ? nB : cB + (size_t)(t + 2) * kstep;
            const char* a3 = a2 + kstep; const char* b3 = b2 + kstep;
            if (last && has_next) S.a_ready(nxt);
            if constexpr (SP2) {
            PG8_LDB(B0, 0, 0); PG8_LDB(B1, 0, 1); PG8_SCHED; PG8_LDA(At, 0, 0); PG8_STAGE(PG8_SA(1, 1), a1 + hstep, voffA);
            PG8_WAIT_V(8); PG8_WAIT_L(0); PG8_BAR; PG8_MMA(0, 0, At, B0); PG8_MMA(0, 1, At, B1); PG8_BAR; PG8_SCHED;
            PG8_LDA(At, 0, 1); PG8_STAGE(PG8_SB(0, 0), b2, voffB); PG8_STAGE(PG8_SB(0, 1), b2 + hstep, voffB); PG8_STAGE(PG8_SA(0, 0), a2, voffA);
            PG8_WAIT_V(8); PG8_WAIT_L(0); PG8_BAR; PG8_MMA(1, 0, At, B0); PG8_MMA(1, 1, At, B1); PG8_BAR; PG8_SCHED;
            PG8_LDB(B0, 1, 0); PG8_LDB(B1, 1, 1); PG8_SCHED; PG8_LDA(At, 1, 0); PG8_STAGE(PG8_SA(0, 1), a2 + hstep, voffA);
            PG8_WAIT_V(8); PG8_WAIT_L(0); PG8_BAR; PG8_MMA(0, 0, At, B0); PG8_MMA(0, 1, At, B1); PG8_BAR; PG8_SCHED;
            PG8_LDA(At, 1, 1); PG8_STAGE(PG8_SB(1, 0), b3, voffB); PG8_STAGE(PG8_SB(1, 1), b3 + hstep, voffB); PG8_STAGE(PG8_SA(1, 0), a3, voffA);
            PG8_WAIT_V(8); PG8_WAIT_L(0); PG8_BAR; PG8_MMA(1, 0, At, B0); PG8_MMA(1, 1, At, B1); PG8_BAR; PG8_SCHED;
            } else {
            PG8_LDB(B0, 0, 0); PG8_SCHED; PG8_LDA(At, 0, 0); PG8_STAGE(PG8_SA(1, 1), a1 + hstep, voffA);
            PG8_WAIT_L(8); PG8_BAR; PG8_WAIT_L(0); PG8_MMA(0, 0, At, B0); PG8_BAR; PG8_SCHED;
            PG8_LDB(B1, 0, 1); PG8_STAGE(PG8_SB(0, 0), b2, voffB);
            PG8_BAR; PG8_WAIT_L(0); PG8_MMA(0, 1, At, B1); PG8_BAR;
            PG8_LDA(At, 0, 1); PG8_STAGE(PG8_SA(0, 0), a2, voffA);
            PG8_BAR; PG8_WAIT_L(0); PG8_MMA(1, 0, At, B0); PG8_BAR; PG8_SCHED;
            PG8_STAGE(PG8_SB(0, 1), b2 + hstep, voffB);
            PG8_WAIT_V(6); PG8_BAR; PG8_MMA(1, 1, At, B1); PG8_BAR;
            PG8_LDB(B0, 1, 0); PG8_SCHED; PG8_LDA(At, 1, 0); PG8_STAGE(PG8_SA(0, 1), a2 + hstep, voffA);
            PG8_WAIT_L(8); PG8_BAR; PG8_WAIT_L(0); PG8_MMA(0, 0, At, B0); PG8_BAR; PG8_SCHED;
            PG8_LDB(B1, 1, 1); PG8_STAGE(PG8_SB(1, 0), b3, voffB);
            PG8_BAR; PG8_WAIT_L(0); PG8_MMA(0, 1, At, B1); PG8_BAR;
            PG8_LDA(At, 1, 1); PG8_STAGE(PG8_SA(1, 0), a3, voffA);
            PG8_BAR; PG8_WAIT_L(0); PG8_MMA(1, 0, At, B0); PG8_BAR; PG8_SCHED;
            PG8_STAGE(PG8_SB(1, 1), b3 + hstep, voffB);
            PG8_WAIT_V(6); PG8_BAR; PG8_MMA(1, 1, At, B1); PG8_BAR;
            }
        }
        if constexpr (ALIGN_EPI) { if (wr == 0) PG8_BAR; }
        if constexpr (!Epi::AFTER_DRAIN) { E(acc, cur, wr, wc, fr, fq); S.done(cur); }
        if (!has_next) break;
#pragma unroll
        for (int a = 0; a < 2; ++a)
#pragma unroll
            for (int b = 0; b < 2; ++b)
#pragma unroll
                for (int m = 0; m < 4; ++m)
#pragma unroll
                    for (int n = 0; n < 2; ++n) acc[a][b][m][n] = (f32x4){0.f, 0.f, 0.f, 0.f};
        cur = nxt; cA = nA; cB = nB; ++ui;
        if constexpr (ALIGN_EPI) { if (wr == 1) PG8_BAR; }
    }
    PG8_WAIT_V(0);
    if constexpr (!ALIGN_EPI) { if (wr == 0) PG8_BAR; }
    PG8_BAR;
    if constexpr (Epi::AFTER_DRAIN) { E.fused(acc, cur, wr, wc, fr, fq, lds, wid, lane); S.done(cur); }
#undef PG8_SA
#undef PG8_SB
#undef PG8_STAGE
#undef PG8_LDA
#undef PG8_LDB
#undef PG8_MMA
#undef PG8_WAIT_V
#undef PG8_WAIT_L
#undef PG8_BAR
#undef PG8_SCHED
}
}

constexpr int NWAVES = 8;
constexpr int DM = 4096, MP = 8192, NB = 8, DS = 64, MS = NB * DS, M = MP + MS, PAST = 2048, KS = PAST + DS  ;
constexpr int DFF = 11008, GW = 2048, NG = 16, NH = 16, KVR = 512, QR = 1024, INW = 5696, ZW = 3648, QW = 3072;
constexpr int LATROWS = MP + NB * KS;
constexpr int NMOD = 9 * DM;
constexpr float LN_EPS = 1e-5f, RMS_EPS = 1e-6f;
constexpr float QSCALE = 0.07216878364870322f * 1.4426950408889634f;
#ifndef MK_PER_PHASE
#define MK_PER_PHASE 0
#endif
constexpr int N_PHASES = 14;
constexpr int GATE_P7 = 2;

constexpr size_t MiB = 1u << 20;
constexpr size_t WS_CTL = 0, CTL_ZERO_BYTES = 1 * MiB;
constexpr size_t WS_MOD = 1 * MiB, WS_ROPE = 3 * MiB;
constexpr size_t WS_WGU1 = 8 * MiB, WS_WD1 = WS_WGU1 + 172 * MiB, WS_WGU2 = WS_WD1 + 86 * MiB, WS_WD2 = WS_WGU2 + 172 * MiB;
constexpr size_t WS_WIN = WS_WD2 + 86 * MiB, WS_WUQ = WS_WIN + 46 * MiB, WS_WUK = WS_WUQ + 6 * MiB, WS_WUV = WS_WUK + 2 * MiB, WS_WOUT = WS_WUV + 2 * MiB;
constexpr size_t WS_H = WS_WOUT + 32 * MiB, WS_ACT = WS_H + 68 * MiB, WS_T = WS_ACT + 183 * MiB, WS_X = WS_T + 136 * MiB;
constexpr size_t WS_U = WS_X + 136 * MiB, WS_Z = WS_U + 34 * MiB, WS_VN = WS_Z + 122 * MiB, WS_CQN = WS_VN + 34 * MiB, WS_LAT = WS_CQN + 17 * MiB;
constexpr size_t WS_Q = WS_LAT + 25 * MiB, WS_KALL = WS_Q + 51 * MiB, WS_VTP = WS_KALL + 147 * MiB, WS_VTS = WS_VTP + 32 * MiB, WS_MIX = WS_VTS + 66 * MiB;
constexpr size_t WS_SL = WS_MIX + 68 * MiB, WS_KRS = WS_SL + 64 * MiB;
constexpr size_t WS_END = WS_KRS + 17 * MiB;
constexpr int CW_TMO = 0, CW_QUEUE = 1024, CW_CONV = 1088, CW_GATEQ = 1280, CW_BAR = 4096;
constexpr size_t O_Y = 0, O_LATP = (size_t)M * DM, O_KRP = O_LATP + (size_t)MP * KVR, O_LATS = O_KRP + (size_t)MP * 64, O_KRS = O_LATS + (size_t)MS * KVR, O_VS = O_KRS + (size_t)MS * 64;

constexpr int RING_OFF = 0, RING_BYTES = 131072;
constexpr int LDSCTL_OFF = RING_BYTES, MISC_OFF = LDSCTL_OFF + 320;
constexpr int LDS_BYTES = 147456;

#define GAS __attribute__((address_space(1)))
#define LAS __attribute__((address_space(3)))
typedef unsigned short bf16;
typedef unsigned v4u __attribute__((ext_vector_type(4)));
typedef float f32x4 __attribute__((ext_vector_type(4)));
typedef short bf16x8 __attribute__((ext_vector_type(8)));
typedef GAS unsigned gu32;
typedef GAS unsigned long long gu64;
#define RLX_AGENT __ATOMIC_RELAXED, __HIP_MEMORY_SCOPE_AGENT
#define LDS_WAIT() asm volatile("s_waitcnt lgkmcnt(0)" ::: "memory")
#define VM_WAIT() asm volatile("s_waitcnt vmcnt(0)" ::: "memory")
__device__ __forceinline__ unsigned long long rt() { return __builtin_amdgcn_s_memrealtime(); }
__device__ __forceinline__ unsigned f2bf(float f) { unsigned u = __builtin_bit_cast(unsigned, f); return (u + 0x7fffu + ((u >> 16) & 1u)) >> 16; }
__device__ __forceinline__ unsigned pk2(float lo, float hi) { return f2bf(lo) | (f2bf(hi) << 16); }
#define XB_TMO      128
#define XB_XCNT(j)  (256  + 64 * (j))
#define XB_XSUB(j)  (1280 + 64 * (j))
#define XB_XGEN(j)  (2304 + 64 * (j))
#define XB_TOP      3328
#define XB_TOPGEN   3392
#define XCD_BAR_WORDS 3456
#define XB_SPIN_CAP (1u << 18)

__device__ __forceinline__ unsigned xb_ld(unsigned* p)              { return __hip_atomic_load(p, __ATOMIC_RELAXED, __HIP_MEMORY_SCOPE_AGENT); }
__device__ __forceinline__ unsigned xb_add(unsigned* p, unsigned v) { return __hip_atomic_fetch_add(p, v, __ATOMIC_RELAXED, __HIP_MEMORY_SCOPE_AGENT); }
__device__ __forceinline__ unsigned xb_xcc_id() { return (unsigned)__builtin_amdgcn_s_getreg((3 << 11) | 20) & 0xFu; }
#define XB_SPIN(cond, bar) do { unsigned _sp = 0; while (cond) { __builtin_amdgcn_s_sleep(1); \
    if ((++_sp & 255u) == 0u) { if (xb_ld(&(bar)[XB_TMO])) break; if (_sp > XB_SPIN_CAP) { atomicAdd(&(bar)[XB_TMO], 1u); break; } } } } while (0)

__device__ __forceinline__ int fresh_lane() { int l; asm volatile("v_mbcnt_lo_u32_b32 %0, -1, 0\n\tv_mbcnt_hi_u32_b32 %0, -1, %0" : "=v"(l)); return l; }
struct XcdBarrier {
    unsigned* bar; unsigned x; int w0;
    volatile LAS unsigned* st;
};

__device__ __forceinline__ XcdBarrier xcd_barrier_post(unsigned* bar, volatile LAS unsigned* st, int wave) {
    XcdBarrier b; b.bar = bar; b.x = xb_xcc_id(); b.st = st; b.w0 = (wave == 0);
    if (b.w0 && fresh_lane() == 0) (void)xb_add(&bar[XB_XCNT(b.x)], 1u);
    return b;
}
__device__ __forceinline__ void xcd_barrier_complete(unsigned* bar, unsigned x, unsigned& nloc, unsigned& nx) {
    const unsigned G = gridDim.x * gridDim.y * gridDim.z;
    unsigned sum, cnt, mine, sp = 0u;
    for (;;) {
        sum = 0u; cnt = 0u; mine = 0u;
#pragma unroll
        for (unsigned j = 0; j < 16; ++j) { const unsigned c = xb_ld(&bar[XB_XCNT(j)]); sum += c; cnt += (c > 0u) ? 1u : 0u; mine = (j == x) ? c : mine; }
        if (sum == G) break;
        __builtin_amdgcn_s_sleep(1);
        if ((++sp & 255u) == 0u) { if (xb_ld(&bar[XB_TMO])) break; if (sp > XB_SPIN_CAP) { atomicAdd(&bar[XB_TMO], 1u); break; } }
    }
    nloc = mine > 0u ? mine : 1u; nx = cnt > 0u ? cnt : 1u;
}

__device__ __forceinline__ void xcd_barrier(const XcdBarrier& b) {
    asm volatile("s_waitcnt vmcnt(0)" ::: "memory");
    __syncthreads();
    if (b.w0 && fresh_lane() == 0) {
        unsigned* bar = b.bar;
        __builtin_amdgcn_s_waitcnt(0);
        unsigned nloc = b.st[0], nx = b.st[1];
        if (nloc == 0u) { xcd_barrier_complete(bar, b.x, nloc, nx); b.st[0] = nloc; b.st[1] = nx; }
        const unsigned old = xb_add(&bar[XB_XSUB(b.x)], 1u);
        const unsigned gen = old / nloc;
        if (old + 1u == (gen + 1u) * nloc) {
            __builtin_amdgcn_fence(__ATOMIC_RELEASE, "agent");
            asm volatile("s_waitcnt vmcnt(0)" ::: "memory");
            const unsigned og = xb_add(&bar[XB_TOP], 1u);
            const unsigned tg = og / nx;
            if (og + 1u == (tg + 1u) * nx) xb_add(&bar[XB_TOPGEN], 1u);
            else XB_SPIN(xb_ld(&bar[XB_TOPGEN]) == tg, bar);
            __builtin_amdgcn_fence(__ATOMIC_ACQUIRE, "agent");
            xb_add(&bar[XB_XGEN(b.x)], 1u);
            asm volatile("s_waitcnt vmcnt(0)" ::: "memory");
        } else {
            XB_SPIN(xb_ld(&bar[XB_XGEN(b.x)]) == gen, bar);
            __builtin_amdgcn_fence(__ATOMIC_ACQUIRE, "agent");
            asm volatile("s_waitcnt vmcnt(0)" ::: "memory");
        }
    }
    __syncthreads();
}


struct Frame {
    LAS unsigned char* lds;
    volatile LAS unsigned* MISC;
    gu32* ctl;
    int tid, lane, wave, vcu, G;
};
__device__ __forceinline__ float wave_sum(float v) {
#pragma unroll
    for (int o = 1; o < 64; o <<= 1) v += __shfl_xor(v, o);
    return v;
}
__device__ __forceinline__ int r_sidx(int r) { return r < MP ? 0 : 1 + ((r - MP) >> 6); }
__device__ __forceinline__ int r_pos(int r) { return r < MP ? r : PAST + ((r - MP) & 63); }
__device__ __forceinline__ int r_keyrow(int r) { return r < MP ? r : MP + ((r - MP) >> 6) * KS + PAST + ((r - MP) & 63); }

__device__ __forceinline__ void transpose_item(const float* W, int K, int N, bf16* WT, int k0, int n0, int rowA, int rowB, LAS unsigned char* tile, int lane) {
    const int l15 = lane & 15, lq = lane >> 4;
    f32x4 v[16];
    const float* src = W + (size_t)(k0 + 2 * lq) * N + n0 + 4 * l15;
#pragma unroll
    for (int i = 0; i < 16; ++i) v[i] = *(const f32x4*)(src + (size_t)(8 * (i >> 1) + (i & 1)) * N);
#pragma unroll
    for (int p = 0; p < 8; ++p)
#pragma unroll
        for (int e = 0; e < 4; ++e) { const int n = 4 * l15 + e;
            *(LAS unsigned*)(tile + n * 128 + (((p ^ (l15 & 7)) << 4) | (4 * lq))) = pg8::cvt_pk_bf16(v[2 * p][e], v[2 * p + 1][e]); }
    LDS_WAIT(); asm volatile("" ::: "memory");
#pragma unroll
    for (int j = 0; j < 8; ++j) { const int n = (lane >> 3) + 8 * j, c = lane & 7;
        const v4u o = *(const LAS v4u*)(tile + n * 128 + ((c ^ ((n >> 2) & 7)) << 4));
        const int row = (n < 32 ? rowA : rowB - 32) + n;
        *(GAS v4u*)(WT + (size_t)row * K + k0 + 8 * c) = o; }
    LDS_WAIT(); asm volatile("" ::: "memory");
}
__device__ __forceinline__ int map_gu(int n0) { const int up = n0 >= DFF, j = up ? n0 - DFF : n0; return 256 * (j >> 7) + (up ? 128 : 0) + (j & 127); }
__device__ __forceinline__ int map_uq(int n0) { const int head = n0 / 192, e = n0 - head * 192;
    if (e < 128) return head * 128 + e;
    return 2048 + 256 * (head >> 2) + (e >= 160 ? 128 : 0) + 32 * (head & 3) + (e & 31); }
__device__ __forceinline__ int map_ukv(int n0) { const int head = n0 >> 8, e = n0 & 255; return (e < 128 ? 0 : 2048) + head * 128 + (e & 127); }

template <int MAP> __device__ __forceinline__ void transpose_matrix(Frame& F, const float* W, int K, int N, bf16* WT, int& it0) {
    LAS unsigned char* tile = F.lds + RING_OFF + F.wave * 8192;
    const int gw = F.vcu * NWAVES + F.wave, NGW = F.G * NWAVES;
    const int nblk = N / 64, nitems = (K / 64) * nblk;
    int first = (gw - (it0 % NGW) + NGW) % NGW;
    for (int it = first; it < nitems; it += NGW) {
        const int kb = it / nblk, nb = it - kb * nblk, n0 = 64 * nb;
        const int rowA = MAP == 1 ? map_gu(n0) : MAP == 2 ? map_uq(n0) : MAP == 3 ? map_ukv(n0) : n0;
        const int rowB = MAP == 1 ? map_gu(n0 + 32) : MAP == 2 ? map_uq(n0 + 32) : MAP == 3 ? map_ukv(n0 + 32) : n0 + 32;
        transpose_item(W, K, N, WT, 64 * kb, n0, rowA, rowB, tile, F.lane);
    }
    it0 += nitems;
}

struct ConvMat { const float* W; bf16* WT; int K, N, map; };
struct ConvIt { const float* W; bf16* WT; int K, N, k0, n0, rowA, rowB; };
constexpr int CONV0_ITEMS = 11008 + 5696 + 768 + 512 + 4096 + 22016, CONV1_ITEMS = 11008;
constexpr int CONV_BATCH = 64;
static_assert(CONV0_ITEMS % CONV_BATCH == 0 && CONV1_ITEMS % CONV_BATCH == 0, "conversion batches");
__device__ __forceinline__ ConvIt conv_decode(int group, int it, const float* const* in, unsigned char* ws) {
    ConvMat cm;
    if (group == 1) { cm = ConvMat{in[25], (bf16*)(ws + WS_WD2), DFF, DM, 0}; }
    else if (it < 11008) { cm = ConvMat{in[9], (bf16*)(ws + WS_WD1), DFF, DM, 0}; }
    else if (it < 16704) { it -= 11008; cm = ConvMat{in[12], (bf16*)(ws + WS_WIN), DM, INW, 0}; }
    else if (it < 17472) { it -= 16704; cm = ConvMat{in[18], (bf16*)(ws + WS_WUQ), QR, QW, 2}; }
    else if (it < 17984) { it -= 17472; cm = ConvMat{in[20], (bf16*)(ws + WS_WUK), KVR, 4096, 3}; }
    else if (it < 22080) { it -= 17984; cm = ConvMat{in[21], (bf16*)(ws + WS_WOUT), DM, DM, 0}; }
    else { it -= 22080; cm = ConvMat{in[24], (bf16*)(ws + WS_WGU2), DM, 2 * DFF, 1}; }
    const int nblk = cm.N / 64, kb = it / nblk, nb = it - kb * nblk, n0 = 64 * nb;
    int rowA = n0, rowB = n0 + 32;
    if (cm.map == 1) { rowA = map_gu(n0); rowB = map_gu(n0 + 32); } else if (cm.map == 2) { rowA = map_uq(n0); rowB = map_uq(n0 + 32); } else if (cm.map == 3) { rowA = map_ukv(n0); rowB = map_ukv(n0 + 32); }
    return ConvIt{cm.W, cm.WT, cm.K, cm.N, 64 * kb, n0, rowA, rowB};
}
__device__ __forceinline__ void tr_load(f32x4 (&v)[16], const ConvIt& ci, int lane) {
    const float* src = ci.W + (size_t)(ci.k0 + 2 * (lane >> 4)) * ci.N + ci.n0 + 4 * (lane & 15);
#pragma unroll
    for (int i = 0; i < 16; ++i) v[i] = __builtin_nontemporal_load((const f32x4*)(src + (size_t)(8 * (i >> 1) + (i & 1)) * ci.N));
    __builtin_amdgcn_sched_barrier(0);
}
__device__ __forceinline__ void tr_store(const f32x4 (&v)[16], const ConvIt& ci, LAS unsigned char* tile, int lane) {
    const int l15 = lane & 15, lq = lane >> 4;
#pragma unroll
    for (int p = 0; p < 8; ++p)
#pragma unroll
        for (int e = 0; e < 4; ++e) { const int n = 4 * l15 + e;
            *(LAS unsigned*)(tile + n * 128 + (((p ^ (l15 & 7)) << 4) | (4 * lq))) = pg8::cvt_pk_bf16(v[2 * p][e], v[2 * p + 1][e]); }
    LDS_WAIT(); asm volatile("" ::: "memory");
#pragma unroll
    for (int j = 0; j < 8; ++j) { const int n = (lane >> 3) + 8 * j, c = lane & 7;
        const v4u o = *(const LAS v4u*)(tile + n * 128 + ((c ^ ((n >> 2) & 7)) << 4));
        const int row = (n < 32 ? ci.rowA : ci.rowB - 32) + n;
        *(GAS v4u*)(ci.WT + (size_t)row * ci.K + ci.k0 + 8 * c) = o; }
    LDS_WAIT(); asm volatile("" ::: "memory");
    __builtin_amdgcn_sched_barrier(0);
}
__device__ __forceinline__ void conv_pull(Frame& F, int group, const float* const* in, unsigned char* ws) {
    const int nb = (group == 0 ? CONV0_ITEMS : CONV1_ITEMS) / CONV_BATCH;
    LAS unsigned char* tile = F.lds + RING_OFF + F.wave * 8192;
    for (;;) {
        if (F.tid == 0) F.MISC[1] = __hip_atomic_fetch_add(F.ctl + CW_CONV + 64 * group, 1u, __ATOMIC_RELAXED, __HIP_MEMORY_SCOPE_AGENT);
        LDS_WAIT(); __syncthreads();
        const int b = __builtin_amdgcn_readfirstlane((int)F.MISC[1]);
        __syncthreads();
        if (b >= nb) break;
        const int it0 = CONV_BATCH * b + F.wave;
        f32x4 va[16], vb[16];
        ConvIt ca = conv_decode(group, it0, in, ws), cb;
        tr_load(va, ca, F.lane);
#pragma unroll 1
        for (int j = 0; j < 8; j += 2) {
            cb = conv_decode(group, it0 + 8 * (j + 1), in, ws); tr_load(vb, cb, F.lane);
            tr_store(va, ca, tile, F.lane);
            if (j + 2 < 8) { ca = conv_decode(group, it0 + 8 * (j + 2), in, ws); tr_load(va, ca, F.lane); }
            tr_store(vb, cb, tile, F.lane);
        }
    }
}

__device__ __forceinline__ void mod_phase(Frame& F, const float* cp, const float* cs, const float* wada, const float* bada, float* mod) {
    LAS float* red = (LAS float*)(F.lds + RING_OFF);
    const int lane = F.lane, w = F.wave;
    for (int cb = F.vcu; cb < NMOD / 144; cb += F.G) {
        const int lc = lane < 36 ? lane : 35;
        const float* wrow = wada + (size_t)(512 * w) * NMOD + cb * 144;
        f32x4 acc[9];
#pragma unroll
        for (int b = 0; b < 9; ++b) acc[b] = (f32x4){0.f, 0.f, 0.f, 0.f};
        for (int kb = 0; kb < 8; ++kb) {
            float sv[9];
            { const int k = 512 * w + 64 * kb + lane;
#pragma unroll
              for (int b = 0; b < 9; ++b) { const float c = b == 0 ? cp[k] : cs[(b - 1) * DM + k]; sv[b] = c * __builtin_amdgcn_rcpf(1.0f + __builtin_amdgcn_exp2f(-1.4426950408889634f * c)); } }
#pragma unroll 1
            for (int k0 = 0; k0 < 64; k0 += 16) {
                f32x4 wv[16];
#pragma unroll
                for (int u = 0; u < 16; ++u) wv[u] = __builtin_nontemporal_load((const f32x4*)(wrow + (size_t)(64 * kb + k0 + u) * NMOD + 4 * lc));
                __builtin_amdgcn_sched_barrier(0);
#pragma unroll
                for (int u = 0; u < 16; ++u)
#pragma unroll
                    for (int b = 0; b < 9; ++b) { const float s = __builtin_bit_cast(float, __builtin_amdgcn_readlane(__builtin_bit_cast(int, sv[b]), k0 + u)); acc[b] += wv[u] * s; }
            }
        }
        if (lane < 36) {
#pragma unroll
            for (int b = 0; b < 9; ++b) *(LAS f32x4*)(red + (w * 9 + b) * 144 + 4 * lane) = acc[b];
        }
        LDS_WAIT(); __syncthreads();
        for (int o = F.tid; o < 9 * 144; o += NWAVES * 64) { const int b = o / 144, c = o - b * 144; float s = bada[cb * 144 + c];
#pragma unroll
            for (int ww = 0; ww < 8; ++ww) s += red[(ww * 9 + b) * 144 + c];
            mod[(size_t)b * NMOD + cb * 144 + c] = s; }
        __syncthreads();
    }
}
__device__ __forceinline__ void rope_phase(Frame& F, float* rope) {
    const int gt = F.vcu * (NWAVES * 64) + F.tid, NT = F.G * NWAVES * 64;
    for (int idx = gt; idx < MP * 32; idx += NT) {
        const int pos = idx >> 5, i = idx & 31;
        const double inv = exp2(-(double)i * (13.287712379549449 / 32.0));
        const double ang = (double)pos * inv;
        const double n = rint(ang * 0.15915494309189535);
        double r = fma(-n, 6.283185307179586, ang); r = fma(-n, 2.4492935982947064e-16, r);
        const float rf = (float)r;
        rope[(size_t)pos * 64 + i] = cosf(rf); rope[(size_t)pos * 64 + 32 + i] = sinf(rf);
    }
}
__device__ __forceinline__ void krope_store16(bf16* krow  , float v, int lane) {
    const unsigned mine = f2bf(v);
    unsigned e[8];
#pragma unroll
    for (int j = 0; j < 8; ++j) e[j] = (unsigned)__shfl((int)mine, 8 * (lane & 7) + j);
    v4u o; o.x = e[0] | (e[1] << 16); o.y = e[2] | (e[3] << 16); o.z = e[4] | (e[5] << 16); o.w = e[6] | (e[7] << 16);
    const int hg = lane >> 3, ch = lane & 7;
    *(GAS v4u*)(krow + hg * 192 + 128 + 8 * ch) = o;
    *(GAS v4u*)(krow + (hg + 8) * 192 + 128 + 8 * ch) = o;
}
__device__ __forceinline__ void cache_phase(Frame& F, const float* clat, const float* ckr, bf16* LAT, bf16* KALL) {
    const int gw = F.vcu * NWAVES + F.wave, NGW = F.G * NWAVES, lane = F.lane;
    for (int rr = gw; rr < NB * PAST; rr += NGW) {
        const int b = rr / PAST, j = rr - b * PAST; const size_t krow = (size_t)MP + (size_t)b * KS + j;
        const f32x4 a = *(const f32x4*)(clat + (size_t)rr * KVR + 8 * lane), c = *(const f32x4*)(clat + (size_t)rr * KVR + 8 * lane + 4);
        v4u o; o.x = pk2(a[0], a[1]); o.y = pk2(a[2], a[3]); o.z = pk2(c[0], c[1]); o.w = pk2(c[2], c[3]);
        *(GAS v4u*)(LAT + krow * KVR + 8 * lane) = o;
        krope_store16(KALL + krow * QW, ckr[(size_t)rr * 64 + lane], lane);
    }
}
__device__ __forceinline__ void modulate_rows(Frame& F, const float* xp, const float* xs, const float* mod, int ksh, bf16* H) {
    const int gw = F.vcu * NWAVES + F.wave, NGW = F.G * NWAVES, lane = F.lane;
    LAS float* PL = (LAS float*)(F.lds + RING_OFF + 1024);
    { const float* sh = mod + ksh * DM; const float* sc = sh + DM;
      for (int i = F.tid; i < DM / 4; i += NWAVES * 64) { *(LAS f32x4*)(PL + 4 * i) = *(const f32x4*)(sc + 4 * i) + 1.0f; *(LAS f32x4*)(PL + DM + 4 * i) = *(const f32x4*)(sh + 4 * i); }
      LDS_WAIT(); __syncthreads(); }
    for (int r = gw; r < M; r += NGW) {
        const float* x = r < MP ? xp + (size_t)r * DM : xs + (size_t)(r - MP) * DM;
        f32x4 xv[16];
#pragma unroll
        for (int j = 0; j < 16; ++j) xv[j] = *(const f32x4*)(x + 4 * lane + 256 * j);
        __builtin_amdgcn_sched_barrier(0);
        if (r < MP) {
#pragma unroll
            for (int j = 0; j < 16; ++j) { const int c = 4 * lane + 256 * j;
                const f32x4 h = xv[j] * *(const LAS f32x4*)(PL + c) + *(const LAS f32x4*)(PL + DM + c);
                unsigned long long o = (unsigned long long)pk2(h[0], h[1]) | ((unsigned long long)pk2(h[2], h[3]) << 32);
                *(GAS unsigned long long*)(H + (size_t)r * DM + c) = o; }
        } else {
            const float* sh = mod + (size_t)r_sidx(r) * NMOD + ksh * DM; const float* sc = sh + DM;
#pragma unroll
            for (int jj = 0; jj < 2; ++jj) { f32x4 a[8], s1[8];
#pragma unroll
                for (int j = 0; j < 8; ++j) { const int c = 4 * lane + 256 * (8 * jj + j); a[j] = *(const f32x4*)(sh + c); s1[j] = *(const f32x4*)(sc + c); }
                __builtin_amdgcn_sched_barrier(0);
#pragma unroll
                for (int j = 0; j < 8; ++j) { const int c = 4 * lane + 256 * (8 * jj + j); const f32x4 h = xv[8 * jj + j] * (s1[j] + 1.0f) + a[j];
                    unsigned long long o = (unsigned long long)pk2(h[0], h[1]) | ((unsigned long long)pk2(h[2], h[3]) << 32);
                    *(GAS unsigned long long*)(H + (size_t)r * DM + c) = o; } }
        }
    }
    __syncthreads();
}
__device__ __forceinline__ f32x4 ubf_lo(v4u w, int h) { const unsigned a = h ? w.z : w.x, b = h ? w.w : w.y;
    return (f32x4){__builtin_bit_cast(float, a << 16), __builtin_bit_cast(float, a & 0xffff0000u), __builtin_bit_cast(float, b << 16), __builtin_bit_cast(float, b & 0xffff0000u)}; }
__device__ __forceinline__ v4u pack8(f32x4 a, f32x4 b) { v4u o; o.x = pg8::cvt_pk_bf16(a[0], a[1]); o.y = pg8::cvt_pk_bf16(a[2], a[3]); o.z = pg8::cvt_pk_bf16(b[0], b[1]); o.w = pg8::cvt_pk_bf16(b[2], b[3]); return o; }
template <bool HAS_H, bool XS_F32, bool OUT_F32> __device__ __forceinline__ void ln_rows(Frame& F, const bf16* T, const float* g, const float* b, void* Xout, const float* mod, int ksh, bf16* H,
                                                                 const float* SL, const void* Xs, const float* gate, float gs) {
    const int gw = F.vcu * NWAVES + F.wave, NGW = F.G * NWAVES, lane = F.lane, w = F.wave;
    {
        LAS float* red = (LAS float*)(F.lds + RING_OFF);
        for (int rs = F.vcu; rs < MS; rs += F.G) {
            const int r = MP + rs, c0 = 512 * w + 8 * lane;
            const float* sl = SL + (size_t)rs * DM + c0; const float* gr = gate + (size_t)r_sidx(r) * NMOD + c0;
            f32x4 sa[8][2], x0, x1; v4u xw;
#pragma unroll
            for (int p = 0; p < 8; ++p) { sa[p][0] = *(const f32x4*)(sl + (size_t)p * MS * DM); sa[p][1] = *(const f32x4*)(sl + (size_t)p * MS * DM + 4); }
            if (XS_F32) { const float* xr = (const float*)Xs + (size_t)rs * DM + c0; x0 = *(const f32x4*)xr; x1 = *(const f32x4*)(xr + 4); }
            else xw = *(const GAS v4u*)((const bf16*)Xs + (size_t)rs * DM + c0);
            const f32x4 g0 = *(const f32x4*)gr, g1 = *(const f32x4*)(gr + 4);
            __builtin_amdgcn_sched_barrier(0);
            if (!XS_F32) { x0 = ubf_lo(xw, 0); x1 = ubf_lo(xw, 1); }
            f32x4 a0 = sa[0][0], a1 = sa[0][1];
#pragma unroll
            for (int p = 1; p < 8; ++p) { a0 += sa[p][0]; a1 += sa[p][1]; }
            f32x4 v0 = x0 * 1.189207115002721f + (g0 * gs) * a0, v1 = x1 * 1.189207115002721f + (g1 * gs) * a1;
            float s = ((v0[0] + v0[1]) + (v0[2] + v0[3])) + ((v1[0] + v1[1]) + (v1[2] + v1[3]));
            s = wave_sum(s); if (lane == 0) red[w] = s;
            LDS_WAIT(); __syncthreads();
            float tot = 0.f;
#pragma unroll
            for (int ww = 0; ww < 8; ++ww) tot += red[ww];
            const float mean = tot * (1.f / DM);
            v0 = v0 - mean; v1 = v1 - mean;
            float q = ((v0[0] * v0[0] + v0[1] * v0[1]) + (v0[2] * v0[2] + v0[3] * v0[3])) + ((v1[0] * v1[0] + v1[1] * v1[1]) + (v1[2] * v1[2] + v1[3] * v1[3]));
            q = wave_sum(q); if (lane == 0) red[8 + w] = q;
            LDS_WAIT(); __syncthreads();
            float tq = 0.f;
#pragma unroll
            for (int ww = 0; ww < 8; ++ww) tq += red[8 + ww];
            const float rstd = 1.0f / sqrtf(tq * (1.f / DM) + LN_EPS);
            const float* sh = mod + (size_t)r_sidx(r) * NMOD + ksh * DM + c0; const float* sc = sh + DM;
            const f32x4 pg0 = *(const f32x4*)(g + c0), pg1 = *(const f32x4*)(g + c0 + 4), pb0 = *(const f32x4*)(b + c0), pb1 = *(const f32x4*)(b + c0 + 4);
            f32x4 ps0 = pg0, ps1 = pg0, ph0 = pg0, ph1 = pg0;
            if (HAS_H) { ps0 = *(const f32x4*)sc; ps1 = *(const f32x4*)(sc + 4); ph0 = *(const f32x4*)sh; ph1 = *(const f32x4*)(sh + 4); }
            __builtin_amdgcn_sched_barrier(0);
            const f32x4 y0 = v0 * rstd * pg0 + pb0, y1 = v1 * rstd * pg1 + pb1;
            if (OUT_F32) { float* xo = (float*)Xout + (size_t)r * DM + c0; *(f32x4*)xo = y0; *(f32x4*)(xo + 4) = y1; }
            else *(GAS v4u*)((bf16*)Xout + (size_t)r * DM + c0) = pack8(y0, y1);
            if (HAS_H) { const f32x4 h0 = y0 * (ps0 + 1.0f) + ph0, h1 = y1 * (ps1 + 1.0f) + ph1;
                *(GAS v4u*)(H + (size_t)r * DM + c0) = pack8(h0, h1); }
            __syncthreads();
        }
    }
    LAS float* PL = (LAS float*)(F.lds + RING_OFF + 1024);
    { const float* sh = mod + ksh * DM; const float* sc = sh + DM;
      for (int i = F.tid; i < DM / 4; i += NWAVES * 64) { const f32x4 gv = *(const f32x4*)(g + 4 * i), bv = *(const f32x4*)(b + 4 * i);
          *(LAS f32x4*)(PL + 4 * i) = gv; *(LAS f32x4*)(PL + DM + 4 * i) = bv;
          if (HAS_H) { const f32x4 s1 = *(const f32x4*)(sc + 4 * i) + 1.0f, hv = *(const f32x4*)(sh + 4 * i);
              *(LAS f32x4*)(PL + 2 * DM + 4 * i) = gv * s1; *(LAS f32x4*)(PL + 3 * DM + 4 * i) = bv * s1 + hv; } }
      LDS_WAIT(); __syncthreads(); }
    for (int r = gw; r < MP; r += NGW) {
        asm volatile("" ::: "memory");
        const bf16* t = T + (size_t)r * DM + 8 * lane;
        v4u tw[8];
#pragma unroll
        for (int j = 0; j < 8; ++j) tw[j] = *(const GAS v4u*)(t + 512 * j);
        __builtin_amdgcn_sched_barrier(0);
        f32x4 v[16]; float s = 0.f;
#pragma unroll
        for (int j = 0; j < 8; ++j) { v[2 * j] = ubf_lo(tw[j], 0); v[2 * j + 1] = ubf_lo(tw[j], 1); }
#pragma unroll
        for (int j = 0; j < 16; ++j) s += (v[j][0] + v[j][1]) + (v[j][2] + v[j][3]);
        const float mean = wave_sum(s) * (1.f / DM); float q = 0.f;
#pragma unroll
        for (int j = 0; j < 16; ++j) { v[j] = v[j] - mean; q += (v[j][0] * v[j][0] + v[j][1] * v[j][1]) + (v[j][2] * v[j][2] + v[j][3] * v[j][3]); }
        const float rstd = 1.0f / sqrtf(wave_sum(q) * (1.f / DM) + LN_EPS);
#pragma unroll
        for (int j = 0; j < 8; ++j) { const int c = 8 * lane + 512 * j; const f32x4 n0 = v[2 * j] * rstd, n1 = v[2 * j + 1] * rstd;
            const f32x4 y0 = n0 * *(const LAS f32x4*)(PL + c) + *(const LAS f32x4*)(PL + DM + c), y1 = n1 * *(const LAS f32x4*)(PL + c + 4) + *(const LAS f32x4*)(PL + DM + c + 4);
            if (OUT_F32) { float* xo = (float*)Xout + (size_t)r * DM + c; *(f32x4*)xo = y0; *(f32x4*)(xo + 4) = y1; }
            else *(GAS v4u*)((bf16*)Xout + (size_t)r * DM + c) = pack8(y0, y1);
            if (HAS_H) { const f32x4 h0 = n0 * *(const LAS f32x4*)(PL + 2 * DM + c) + *(const LAS f32x4*)(PL + 3 * DM + c), h1 = n1 * *(const LAS f32x4*)(PL + 2 * DM + c + 4) + *(const LAS f32x4*)(PL + 3 * DM + c + 4);
                *(GAS v4u*)(H + (size_t)r * DM + c) = pack8(h0, h1); }
            if (j & 1) __builtin_amdgcn_sched_barrier(0); }
    }
    __syncthreads();
}
__device__ __forceinline__ void mixer_rows(Frame& F, const bf16* Z, const float* lng, const float* lnb, const float* qg, const float* kvg, const float* rope,
                                           bf16* VN, bf16* CQN, bf16* LAT, bf16* KALL, float* out, const float* KRS) {
    const int gw = F.vcu * NWAVES + F.wave, NGW = F.G * NWAVES, lane = F.lane;
    LAS float* PL = (LAS float*)(F.lds + RING_OFF + 1024);
    for (int i = F.tid; i < 5632 / 4; i += NWAVES * 64) { const int c = 4 * i;
        const float* src = c < 2048 ? lng + c : c < 4096 ? lnb + (c - 2048) : c < 5120 ? qg + (c - 4096) : kvg + (c - 5120);
        *(LAS f32x4*)(PL + c) = *(const f32x4*)src; }
    LDS_WAIT(); __syncthreads();
    for (int r = gw; r < M; r += NGW) {
        asm volatile("" ::: "memory");
        const bf16* z = Z + (size_t)r * 3584 + 8 * lane;
        const bool smp = r >= MP; const int rs = r - MP;
        v4u zw[7]; float kp[8];
#pragma unroll
        for (int j = 0; j < 7; ++j) zw[j] = *(const GAS v4u*)(z + 512 * j);
#pragma unroll
        for (int p = 0; p < 8; ++p) kp[p] = KRS[((size_t)p * M + r) * 64 + lane];
        const int i32 = lane & 31; const float rc = rope[(size_t)r_pos(r) * 64 + i32], rsn = rope[(size_t)r_pos(r) * 64 + 32 + i32];
        __builtin_amdgcn_sched_barrier(0);
        f32x4 v[8], cq[4], ck[2];
#pragma unroll
        for (int j = 0; j < 4; ++j) { v[2 * j] = ubf_lo(zw[j], 0); v[2 * j + 1] = ubf_lo(zw[j], 1); }
#pragma unroll
        for (int j = 0; j < 2; ++j) { cq[2 * j] = ubf_lo(zw[4 + j], 0); cq[2 * j + 1] = ubf_lo(zw[4 + j], 1); }
        ck[0] = ubf_lo(zw[6], 0); ck[1] = ubf_lo(zw[6], 1);
        float s = 0.f, q1 = 0.f, q2 = 0.f;
#pragma unroll
        for (int j = 0; j < 8; ++j) s += (v[j][0] + v[j][1]) + (v[j][2] + v[j][3]);
#pragma unroll
        for (int j = 0; j < 4; ++j) q1 += (cq[j][0] * cq[j][0] + cq[j][1] * cq[j][1]) + (cq[j][2] * cq[j][2] + cq[j][3] * cq[j][3]);
#pragma unroll
        for (int j = 0; j < 2; ++j) q2 += (ck[j][0] * ck[j][0] + ck[j][1] * ck[j][1]) + (ck[j][2] * ck[j][2] + ck[j][3] * ck[j][3]);
        s = wave_sum(s); q1 = wave_sum(q1); q2 = wave_sum(q2);
        const float mean = s * (1.f / GW); float q = 0.f;
#pragma unroll
        for (int j = 0; j < 8; ++j) { v[j] = v[j] - mean; q += (v[j][0] * v[j][0] + v[j][1] * v[j][1]) + (v[j][2] * v[j][2] + v[j][3] * v[j][3]); }
        const float rstd = 1.0f / sqrtf(wave_sum(q) * (1.f / GW) + LN_EPS);
        const float rq = 1.0f / sqrtf(q1 * (1.f / QR) + RMS_EPS), rk = 1.0f / sqrtf(q2 * (1.f / KVR) + RMS_EPS);
#pragma unroll
        for (int j = 0; j < 4; ++j) { const int c = 8 * lane + 512 * j;
            const f32x4 y0 = v[2 * j] * rstd * *(const LAS f32x4*)(PL + c) + *(const LAS f32x4*)(PL + 2048 + c), y1 = v[2 * j + 1] * rstd * *(const LAS f32x4*)(PL + c + 4) + *(const LAS f32x4*)(PL + 2048 + c + 4);
            *(GAS v4u*)(VN + (size_t)r * GW + c) = pack8(y0, y1);
            if (smp) { float* vo = out + O_VS + (size_t)rs * GW + c; *(f32x4*)vo = y0; *(f32x4*)(vo + 4) = y1; } }
#pragma unroll
        for (int j = 0; j < 2; ++j) { const int c = 8 * lane + 512 * j;
            const f32x4 y0 = cq[2 * j] * rq * *(const LAS f32x4*)(PL + 4096 + c), y1 = cq[2 * j + 1] * rq * *(const LAS f32x4*)(PL + 4096 + c + 4);
            *(GAS v4u*)(CQN + (size_t)r * QR + c) = pack8(y0, y1); }
        const size_t krow = (size_t)r_keyrow(r);
        { const int c = 8 * lane; float* lo = (smp ? out + O_LATS + (size_t)rs * KVR : out + O_LATP + (size_t)r * KVR) + c;
          const f32x4 y0 = ck[0] * rk * *(const LAS f32x4*)(PL + 5120 + c), y1 = ck[1] * rk * *(const LAS f32x4*)(PL + 5120 + c + 4);
          *(f32x4*)lo = y0; *(f32x4*)(lo + 4) = y1;
          *(GAS v4u*)(LAT + krow * KVR + c) = pack8(y0, y1); }
        { float x = ((kp[0] + kp[1]) + (kp[2] + kp[3])) + ((kp[4] + kp[5]) + (kp[6] + kp[7]));
          const float xo = __shfl_xor(x, 32);
          const float y = lane < 32 ? x * rc - xo * rsn : x * rc + xo * rsn;
          float* ko = smp ? out + O_KRS + (size_t)rs * 64 : out + O_KRP + (size_t)r * 64;
          ko[lane] = y;
          krope_store16(KALL + krow * QW, y, lane); }
    }
    __syncthreads();
}

typedef float f32x16 __attribute__((ext_vector_type(16)));
__device__ __forceinline__ int crow(int r, int hi) { return (r & 3) + 8 * (r >> 2) + 4 * hi; }
constexpr int GT_STRIDE = 272;
__device__ __forceinline__ void gate_unit(Frame& F, int r0, int L, int g, const bf16* VN, const bf16* U, const float* ws, const float* bs, bf16* MIX) {
    LAS unsigned char* vT = F.lds + RING_OFF;
    const int tid = F.tid, lane = F.lane, w = F.wave, r32 = lane & 31, hi = lane >> 5;
    const int mt = w >> 1; const bool act = 32 * mt < L;
    bf16x8 af[8];
    pg8::u32x2 uu[2][4];
    { const bf16* urow = U + (size_t)(r0 + (act ? 32 * mt + r32 : 0)) * GW + g * 128 + 4 * hi;
#pragma unroll
      for (int nn = 0; nn < 2; ++nn)
#pragma unroll
          for (int g4 = 0; g4 < 4; ++g4) uu[nn][g4] = *(const GAS pg8::u32x2*)(urow + 32 * (2 * (w & 1) + nn) + 8 * g4); }
    { const int t = 32 * mt + r32; const float* wrow = ws + (size_t)g * 128 * 128 + (size_t)t * 128;
      f32x4 wl[8][2];
#pragma unroll
      for (int ks = 0; ks < 8; ++ks) { const int s0 = (act && ks < 2 * mt + 2) ? 16 * ks + 8 * hi : 8 * hi;
          wl[ks][0] = *(const f32x4*)(wrow + s0); wl[ks][1] = *(const f32x4*)(wrow + s0 + 4); }
      __builtin_amdgcn_sched_barrier(0);
#pragma unroll
      for (int ks = 0; ks < 8; ++ks) {
          if (act && ks < 2 * mt + 2) { const int s0 = 16 * ks + 8 * hi;
              const f32x4 a = wl[ks][0], c = wl[ks][1];
              float e[8] = {a[0], a[1], a[2], a[3], c[0], c[1], c[2], c[3]};
#pragma unroll
              for (int j = 0; j < 8; ++j) if (s0 + j > t) e[j] = 0.f;
              v4u aw; aw.x = pk2(e[0], e[1]); aw.y = pk2(e[2], e[3]); aw.z = pk2(e[4], e[5]); aw.w = pk2(e[6], e[7]);
              af[ks] = __builtin_bit_cast(bf16x8, aw); }
          else af[ks] = bf16x8{};
      } }
    for (int id = tid; id < L * 16; id += NWAVES * 64) { const int s = id >> 4, cc = id & 15;
        const v4u d = *(const GAS v4u*)(VN + (size_t)(r0 + s) * GW + g * 128 + cc * 8);
        LAS unsigned short* dst = (LAS unsigned short*)(vT + (cc * 8) * GT_STRIDE + s * 2);
        dst[0 * (GT_STRIDE / 2)] = (unsigned short)(d.x & 0xffff); dst[1 * (GT_STRIDE / 2)] = (unsigned short)(d.x >> 16);
        dst[2 * (GT_STRIDE / 2)] = (unsigned short)(d.y & 0xffff); dst[3 * (GT_STRIDE / 2)] = (unsigned short)(d.y >> 16);
        dst[4 * (GT_STRIDE / 2)] = (unsigned short)(d.z & 0xffff); dst[5 * (GT_STRIDE / 2)] = (unsigned short)(d.z >> 16);
        dst[6 * (GT_STRIDE / 2)] = (unsigned short)(d.w & 0xffff); dst[7 * (GT_STRIDE / 2)] = (unsigned short)(d.w >> 16); }
    LDS_WAIT(); __syncthreads();
    if (act) {
        f32x16 acc[2]; acc[0] = f32x16{}; acc[1] = f32x16{};
        bf16x8 bq[8][2];
#pragma unroll
        for (int ks = 0; ks < 8; ++ks)
#pragma unroll
            for (int nn = 0; nn < 2; ++nn) { const int s0 = ks < 2 * mt + 2 ? 16 * ks + 8 * hi : 8 * hi, c0 = 32 * (2 * (w & 1) + nn) + r32;
                bq[ks][nn] = *(const LAS bf16x8*)(vT + c0 * GT_STRIDE + s0 * 2); }
        __builtin_amdgcn_sched_barrier(0);
#pragma unroll
        for (int ks = 0; ks < 8; ++ks) {
            if (ks < 2 * mt + 2) {
#pragma unroll
                for (int nn = 0; nn < 2; ++nn) acc[nn] = __builtin_amdgcn_mfma_f32_32x32x16_bf16(bq[ks][nn], af[ks], acc[nn], 0, 0, 0);
            }
        }
        const int tt = 32 * mt + r32; const float bias = bs[g * 128 + tt];
        bf16* mrow = MIX + (size_t)(r0 + tt) * DM + g * 128 + 4 * hi;
#pragma unroll
        for (int nn = 0; nn < 2; ++nn)
#pragma unroll
            for (int g4 = 0; g4 < 4; ++g4) { const int co = 32 * (2 * (w & 1) + nn) + 8 * g4;
                const pg8::u32x2 u2 = uu[nn][g4];
                const float u0 = __builtin_bit_cast(float, u2.x << 16), u1 = __builtin_bit_cast(float, u2.x & 0xffff0000u), u2f = __builtin_bit_cast(float, u2.y << 16), u3 = __builtin_bit_cast(float, u2.y & 0xffff0000u);
                pg8::u32x2 o; o.x = pk2(u0 * (acc[nn][4 * g4] + bias), u1 * (acc[nn][4 * g4 + 1] + bias)); o.y = pk2(u2f * (acc[nn][4 * g4 + 2] + bias), u3 * (acc[nn][4 * g4 + 3] + bias));
                *(GAS pg8::u32x2*)(mrow + co) = o; }
    }
    __syncthreads();
}

constexpr int AK_STRIDE = 400, AV_STRIDE = 144, AK_BYTES = 64 * AK_STRIDE, AV_BYTES = 128 * AV_STRIDE, ABUF = AK_BYTES + AV_BYTES;
constexpr float ATT_THR = 8.0f;
__device__ __forceinline__ void attn_unit(Frame& F, const bf16* Qb, const bf16* Kb, const bf16* Vt, int vstride, bf16* Ob, int T_max, int my_nt) {
    const int tid = F.tid, lane = F.lane, w = F.wave, r32 = lane & 31, hi = lane >> 5;
    LAS unsigned char* base = F.lds + RING_OFF;
    const int kg = (tid >> 3) * QW + (tid & 7) * 8, kl = (tid >> 3) * AK_STRIDE + (tid & 7) * 16;
    const int vg = (tid >> 2) * vstride + (tid & 3) * 8, vl = AK_BYTES + (tid >> 2) * AV_STRIDE + (tid & 3) * 16;
    v4u kreg[3], vreg[2];
#define A_LOAD(t) do { _Pragma("unroll") for (int i_ = 0; i_ < 3; ++i_) kreg[i_] = *(const GAS v4u*)(Kb + (size_t)(t) * 64 * QW + kg + 64 * i_); \
                       _Pragma("unroll") for (int i_ = 0; i_ < 2; ++i_) vreg[i_] = *(const GAS v4u*)(Vt + (size_t)(t) * 64 + vg + 32 * i_); } while (0)
#define A_WRITE(buf) do { _Pragma("unroll") for (int i_ = 0; i_ < 3; ++i_) *(LAS v4u*)(base + (buf) * ABUF + kl + 128 * i_) = kreg[i_]; \
                          _Pragma("unroll") for (int i_ = 0; i_ < 2; ++i_) *(LAS v4u*)(base + (buf) * ABUF + vl + 64 * i_) = vreg[i_]; } while (0)
    A_LOAD(0);
    bf16x8 qf[12];
    if (my_nt > 0) {
#pragma unroll
        for (int d0 = 0; d0 < 12; ++d0) qf[d0] = *(const GAS bf16x8*)(Qb + (size_t)(32 * w + r32) * QW + 16 * d0 + 8 * hi);
    } else {
#pragma unroll
        for (int d0 = 0; d0 < 12; ++d0) qf[d0] = bf16x8{};
    }
    A_WRITE(0);
    LDS_WAIT(); __syncthreads();
    f32x16 o[4]; o[0] = f32x16{}; o[1] = f32x16{}; o[2] = f32x16{}; o[3] = f32x16{};
    float m = -1e30f, lsum = 0.f;
    const int koff = r32 * AK_STRIDE + hi * 16, voff = AK_BYTES + r32 * AV_STRIDE + hi * 16;
    for (int t = 0; t < T_max; ++t) {
        const bool more = t + 1 < T_max;
        if (more) A_LOAD(t + 1);
        if (t < my_nt) {
            LAS unsigned char* kb = base + (t & 1) * ABUF + koff; LAS unsigned char* vb = base + (t & 1) * ABUF + voff;
            f32x16 p0 = f32x16{}, p1 = f32x16{};
            bf16x8 fa[4], fb[4];
#define A_KLD(dst, bt) do { _Pragma("unroll") for (int j_ = 0; j_ < 2; ++j_) { dst[2 * j_] = *(const LAS bf16x8*)(kb + (2 * (bt) + j_) * 32); dst[2 * j_ + 1] = *(const LAS bf16x8*)(kb + 32 * AK_STRIDE + (2 * (bt) + j_) * 32); } } while (0)
#define A_KMM(src, bt) do { _Pragma("unroll") for (int j_ = 0; j_ < 2; ++j_) { p0 = __builtin_amdgcn_mfma_f32_32x32x16_bf16(src[2 * j_], qf[2 * (bt) + j_], p0, 0, 0, 0); \
                                                                     p1 = __builtin_amdgcn_mfma_f32_32x32x16_bf16(src[2 * j_ + 1], qf[2 * (bt) + j_], p1, 0, 0, 0); } } while (0)
#define A_FENCE() __builtin_amdgcn_sched_barrier(0)
            A_KLD(fa, 0); A_FENCE();
            A_KLD(fb, 1); A_FENCE(); A_KMM(fa, 0); A_FENCE();
            A_KLD(fa, 2); A_FENCE(); A_KMM(fb, 1); A_FENCE();
            A_KLD(fb, 3); A_FENCE(); A_KMM(fa, 2); A_FENCE();
            A_KLD(fa, 4); A_FENCE(); A_KMM(fb, 3); A_FENCE();
            A_KLD(fb, 5); A_FENCE(); A_KMM(fa, 4); A_FENCE();
#define A_VLD(dst, d0) do { _Pragma("unroll") for (int s_ = 0; s_ < 4; ++s_) dst[s_] = *(const LAS bf16x8*)(vb + (d0) * 32 * AV_STRIDE + s_ * 32); } while (0)
            A_VLD(fa, 0); A_FENCE();
            A_KMM(fb, 5); A_FENCE();
            float mx;
            { float t[12];
              asm volatile("s_nop 15\n\ts_nop 3" : "+v"(p0), "+v"(p1));
#define A_MAX3(d, a, b, c) asm("v_max3_f32 %0, %1, %2, %3" : "=v"(d) : "v"(a), "v"(b), "v"(c))
#pragma unroll
              for (int i = 0; i < 5; ++i) { A_MAX3(t[i], p0[3 * i], p0[3 * i + 1], p0[3 * i + 2]); A_MAX3(t[5 + i], p1[3 * i], p1[3 * i + 1], p1[3 * i + 2]); }
              t[10] = p0[15]; t[11] = p1[15];
              float u0, u1, u2, u3, w0;
              A_MAX3(u0, t[0], t[1], t[2]); A_MAX3(u1, t[3], t[4], t[5]); A_MAX3(u2, t[6], t[7], t[8]); A_MAX3(u3, t[9], t[10], t[11]);
              A_MAX3(w0, u0, u1, u2); A_MAX3(mx, w0, u3, u3);
#undef A_MAX3
            }
            mx = fmaxf(mx, __shfl_xor(mx, 32));
            if (!__all(mx - m <= ATT_THR)) {
                const float mn = fmaxf(m, mx), al = __builtin_amdgcn_exp2f(m - mn); m = mn; lsum *= al;
#pragma unroll
                for (int d0 = 0; d0 < 4; ++d0) o[d0] = o[d0] * al;
            }
            float ps0 = 0.f, ps1 = 0.f, ps2 = 0.f, ps3 = 0.f;
#pragma unroll
            for (int r = 0; r < 16; ++r) { p0[r] = __builtin_amdgcn_exp2f(p0[r] - m); p1[r] = __builtin_amdgcn_exp2f(p1[r] - m); }
#pragma unroll
            for (int r = 0; r < 16; r += 2) { ps0 += p0[r]; ps1 += p0[r + 1]; ps2 += p1[r]; ps3 += p1[r + 1]; }
            lsum += (ps0 + ps1) + (ps2 + ps3);
            bf16x8 pf[4];
            { v4u x;
              x.x = pg8::cvt_pk_bf16(p0[0], p0[1]); x.y = pg8::cvt_pk_bf16(p0[2], p0[3]); x.z = pg8::cvt_pk_bf16(p0[4], p0[5]); x.w = pg8::cvt_pk_bf16(p0[6], p0[7]); pf[0] = __builtin_bit_cast(bf16x8, x);
              x.x = pg8::cvt_pk_bf16(p0[8], p0[9]); x.y = pg8::cvt_pk_bf16(p0[10], p0[11]); x.z = pg8::cvt_pk_bf16(p0[12], p0[13]); x.w = pg8::cvt_pk_bf16(p0[14], p0[15]); pf[1] = __builtin_bit_cast(bf16x8, x);
              x.x = pg8::cvt_pk_bf16(p1[0], p1[1]); x.y = pg8::cvt_pk_bf16(p1[2], p1[3]); x.z = pg8::cvt_pk_bf16(p1[4], p1[5]); x.w = pg8::cvt_pk_bf16(p1[6], p1[7]); pf[2] = __builtin_bit_cast(bf16x8, x);
              x.x = pg8::cvt_pk_bf16(p1[8], p1[9]); x.y = pg8::cvt_pk_bf16(p1[10], p1[11]); x.z = pg8::cvt_pk_bf16(p1[12], p1[13]); x.w = pg8::cvt_pk_bf16(p1[14], p1[15]); pf[3] = __builtin_bit_cast(bf16x8, x); }
#define A_VMM(src, d0) do { _Pragma("unroll") for (int s_ = 0; s_ < 4; ++s_) o[d0] = __builtin_amdgcn_mfma_f32_32x32x16_bf16(src[s_], pf[s_], o[d0], 0, 0, 0); } while (0)
            A_FENCE();
            A_VLD(fb, 1); A_FENCE(); A_VMM(fa, 0); A_FENCE();
            A_VLD(fa, 2); A_FENCE(); A_VMM(fb, 1); A_FENCE();
            A_VLD(fb, 3); A_FENCE(); A_VMM(fa, 2); A_FENCE();
            A_VMM(fb, 3); A_FENCE();
#undef A_KLD
#undef A_KMM
#undef A_VLD
#undef A_VMM
#undef A_FENCE
        }
        if (more) A_WRITE((t + 1) & 1);
        LDS_WAIT(); __syncthreads();
    }
    if (my_nt > 0) {
        const float lt = lsum + __shfl_xor(lsum, 32), inv = 1.0f / lt;
        bf16* orow = Ob + (size_t)(32 * w + r32) * DM + 4 * hi;
#pragma unroll
        for (int d0 = 0; d0 < 4; ++d0)
#pragma unroll
            for (int g4 = 0; g4 < 4; ++g4) {
                pg8::u32x2 wv; wv.x = pg8::cvt_pk_bf16(o[d0][4 * g4] * inv, o[d0][4 * g4 + 1] * inv); wv.y = pg8::cvt_pk_bf16(o[d0][4 * g4 + 2] * inv, o[d0][4 * g4 + 3] * inv);
                *(GAS pg8::u32x2*)(orow + 32 * d0 + 8 * g4) = wv;
            }
    }
#undef A_LOAD
#undef A_WRITE
}

struct Args { const float* in[28]; float* out; unsigned char* ws; int ph_lo, ph_hi; };
__global__ void __launch_bounds__(NWAVES * 64, 2) mega_fwd(Args args) {
    extern __shared__ __attribute__((aligned(16))) unsigned char lds[];
    Frame F;
    F.lds = (LAS unsigned char*)lds;
    F.MISC = (volatile LAS unsigned*)(F.lds + MISC_OFF);
    F.wave = __builtin_amdgcn_readfirstlane((int)threadIdx.x >> 6);
#define FRESH_IDS() do { F.lane = fresh_lane(); F.tid = F.wave * 64 + F.lane; } while (0)
    FRESH_IDS();
    F.G = gridDim.x; { const int bx = blockIdx.x; F.vcu = (F.G % 8 == 0) ? (bx % 8) * (F.G / 8) + bx / 8 : bx; }
    unsigned char* ws = args.ws;
    F.ctl = (gu32*)(ws + WS_CTL);
    for (int u = F.tid; u < (LDS_BYTES - LDSCTL_OFF) / 4; u += NWAVES * 64) ((LAS unsigned*)(F.lds + LDSCTL_OFF))[u] = 0u;
    __syncthreads();
    XcdBarrier bar; bar.bar = (unsigned*)(F.ctl + CW_BAR); bar.x = 0; bar.st = nullptr; bar.w0 = 0;
    if (!MK_PER_PHASE) bar = xcd_barrier_post((unsigned*)(F.ctl + CW_BAR), F.MISC + 8, F.wave);
#define GRID_BAR() do { if (!MK_PER_PHASE) xcd_barrier(bar); } while (0)
    const int lo = args.ph_lo, hi = args.ph_hi;
#define IN(k) (lo <= (k) && (k) < hi)
#define BOTH(k) (IN(k) && IN((k) + 1))

    const float* x_p = args.in[0]; const float* x_s = args.in[1];
    float* mod = (float*)(ws + WS_MOD); float* rope = (float*)(ws + WS_ROPE);
    bf16* WGU1 = (bf16*)(ws + WS_WGU1); bf16* WD1 = (bf16*)(ws + WS_WD1); bf16* WGU2 = (bf16*)(ws + WS_WGU2); bf16* WD2 = (bf16*)(ws + WS_WD2);
    bf16* WIN = (bf16*)(ws + WS_WIN); bf16* WUQ = (bf16*)(ws + WS_WUQ); bf16* WUK = (bf16*)(ws + WS_WUK); bf16* WUV = (bf16*)(ws + WS_WUV); bf16* WOUT = (bf16*)(ws + WS_WOUT);
    bf16* H = (bf16*)(ws + WS_H); bf16* ACT = (bf16*)(ws + WS_ACT); bf16* T = (bf16*)(ws + WS_T); bf16* X = (bf16*)(ws + WS_X);
    bf16* U = (bf16*)(ws + WS_U); bf16* Z = (bf16*)(ws + WS_Z); bf16* VN = (bf16*)(ws + WS_VN); bf16* CQN = (bf16*)(ws + WS_CQN); bf16* LAT = (bf16*)(ws + WS_LAT);
    bf16* Q = (bf16*)(ws + WS_Q); bf16* KALL = (bf16*)(ws + WS_KALL); bf16* VTP = (bf16*)(ws + WS_VTP); bf16* VTS = (bf16*)(ws + WS_VTS); bf16* MIX = (bf16*)(ws + WS_MIX); float* SL = (float*)(ws + WS_SL); float* KRS = (float*)(ws + WS_KRS);

    if (IN(0)) { FRESH_IDS();
        mod_phase(F, args.in[4], args.in[5], args.in[6], args.in[7], mod);
        rope_phase(F, rope);
        cache_phase(F, args.in[2], args.in[3], LAT, KALL);
        int it0 = 0;
        transpose_matrix<1>(F, args.in[8], DM, 2 * DFF, WGU1, it0);
        if (BOTH(0)) GRID_BAR();
    }
    if (IN(1)) { FRESH_IDS(); modulate_rows(F, x_p, x_s, mod, 0, H); if (BOTH(1)) GRID_BAR(); }
    if (IN(2)) { FRESH_IDS();
        const int GD = (F.G == 256) ? 244 : F.G;
        if ((int)blockIdx.x < GD) {
            pg8::Gemm g{H, WGU1, M, 2 * DFF, DM}; pg8::StaticOrder S; S.init(M, 2 * DFF, GD, (int)blockIdx.x, DM);
            pg8::EpiSwiglu E{ACT, DFF};
            pg8::gemm_phase<pg8::EpiSwiglu, pg8::StaticOrder, true, true>(F.lds + RING_OFF, g, S, E, F.tid);
        }
        conv_pull(F, 0, args.in, ws);
        if (BOTH(2)) GRID_BAR();
    }
    if (IN(3)) { FRESH_IDS();
        pg8::Gemm g{ACT, WD1, M, DM, DFF}; pg8::SplitOrder S; S.init(MP, DM, F.G, (int)blockIdx.x, DFF, 8, 32, 32, 16, 0);
        pg8::EpiResid<false> E{x_p, mod + 2 * DM, T, 0.5f, SL};
        pg8::gemm_phase<pg8::EpiResid<false>, pg8::SplitOrder, true, true>(F.lds + RING_OFF, g, S, E, F.tid);
        if (BOTH(3)) GRID_BAR();
    }
    if (IN(4)) { FRESH_IDS(); ln_rows<true, true, false>(F, T, args.in[10], args.in[11], X, mod, 3, H, SL, x_s, mod + 2 * DM, 0.5f); if (BOTH(4)) GRID_BAR(); }
    if (IN(5)) { FRESH_IDS();
        pg8::Gemm g{H, WIN, M, 5888, DM}; pg8::SplitOrder S; S.init(M, 5632, F.G, (int)blockIdx.x, DM, 8, 34, 0, 1, 22);
        pg8::EpiWin E{U, Z, KRS};
        pg8::gemm_phase<pg8::EpiWin, pg8::SplitOrder, true, true>(F.lds + RING_OFF, g, S, E, F.tid);
        if (BOTH(5)) GRID_BAR();
    }
    if (IN(6)) { FRESH_IDS(); mixer_rows(F, Z, args.in[13], args.in[14], args.in[17], args.in[19], rope, VN, CQN, LAT, KALL, args.out, KRS); if (BOTH(6)) GRID_BAR(); }
    if (IN(7)) { FRESH_IDS();
        { pg8::Gemm g{CQN, WUQ, M, QW, QR}; pg8::StaticOrder S; S.init(M, QW, F.G, (int)blockIdx.x, QR);
          pg8::EpiHeads E{Q, QSCALE, 8, rope};
          pg8::gemm_phase<pg8::EpiHeads, pg8::StaticOrder, true, true>(F.lds + RING_OFF, g, S, E, F.tid); }
        { pg8::Gemm g{LAT, WUK, LATROWS, 2048, KVR}; pg8::StaticOrder S; S.init(LATROWS, 2048, F.G, ((int)blockIdx.x + F.G - 152) % F.G, KVR);
          pg8::EpiHeads E{KALL, 1.0f, 8, rope};
          pg8::gemm_phase<pg8::EpiHeads, pg8::StaticOrder, true, true>(F.lds + RING_OFF, g, S, E, F.tid); }
        { pg8::Gemm g{WUV, LAT, 2048, LATROWS, KVR}; pg8::StaticOrder S; S.init(2048, LATROWS, F.G, ((int)blockIdx.x + F.G - 168) % F.G, KVR);
          pg8::EpiVt E{VTP, VTS};
          pg8::gemm_phase<pg8::EpiVt, pg8::StaticOrder, true, true>(F.lds + RING_OFF, g, S, E, F.tid); }
        for (int n = 0; n < GATE_P7 && ((int)blockIdx.x < 152 || (int)blockIdx.x >= 184); ++n) {
            if (F.tid == 0) F.MISC[0] = __hip_atomic_fetch_add(F.ctl + CW_GATEQ, 1u, __ATOMIC_RELAXED, __HIP_MEMORY_SCOPE_AGENT);
            LDS_WAIT(); __syncthreads();
            const int u = __builtin_amdgcn_readfirstlane((int)F.MISC[0]);
            if (u >= 1152) break;
            if (u < 1024) gate_unit(F, 128 * (u >> 4), 128, u & 15, VN, U, args.in[15], args.in[16], MIX);
            else { const int v = u - 1024; gate_unit(F, MP + 64 * (v >> 4), 64, v & 15, VN, U, args.in[15], args.in[16], MIX); }
        }
        if (BOTH(7)) GRID_BAR();
    }
    if (IN(8)) { FRESH_IDS();
        const int xme = (int)xb_xcc_id() & 7;
        for (int sq = 0; sq < 8; ++sq) { const int xq = (xme + sq) & 7;
        for (;;) {
            if (F.tid == 0) F.MISC[0] = __hip_atomic_fetch_add(F.ctl + 2048 + 64 * xq, 1u, __ATOMIC_RELAXED, __HIP_MEMORY_SCOPE_AGENT);
            LDS_WAIT(); __syncthreads();
            const int qi = __builtin_amdgcn_readfirstlane((int)F.MISC[0]);
            __syncthreads();
            if (qi >= 80) break;
            const int hq = xq + 8 * (qi & 1), idx = qi < 48 ? 16 * (qi >> 1) + hq : qi < 64 ? 384 + 16 * ((qi - 48) >> 1) + hq : 128 + 16 * (24 + ((qi - 64) >> 1)) + hq;
            {
                const bf16 *Qb, *Kb, *Vt; bf16* Ob; int vstride, T_max, my_nt;
                if (idx >= 384 && idx < 512) { const int u = idx - 384, b = u >> 4, h = u & 15;
                    Qb = Q + (size_t)(MP + 64 * b) * QW + h * 192; Kb = KALL + (size_t)(MP + b * KS) * QW + h * 192; Vt = VTS + ((size_t)b * 2048 + h * 128) * KS; vstride = KS;
                    Ob = MIX + (size_t)(MP + 64 * b) * DM + 2048 + h * 128; T_max = 33; my_nt = F.wave < 2 ? 33 : 0; }
                else { const int u = idx < 384 ? idx : idx - 128, qb = 31 - (u >> 4), h = u & 15;
                    Qb = Q + (size_t)(256 * qb) * QW + h * 192; Kb = KALL + h * 192; Vt = VTP + (size_t)(h * 128) * MP; vstride = MP;
                    Ob = MIX + (size_t)(256 * qb) * DM + 2048 + h * 128; T_max = 4 * qb + 4; my_nt = 4 * qb + (F.wave >> 1) + 1; }
                attn_unit(F, Qb, Kb, Vt, vstride, Ob, T_max, my_nt);
            }
        }
        }
        for (;;) {
            if (F.tid == 0) F.MISC[0] = __hip_atomic_fetch_add(F.ctl + CW_GATEQ, 1u, __ATOMIC_RELAXED, __HIP_MEMORY_SCOPE_AGENT);
            LDS_WAIT(); __syncthreads();
            const int u = __builtin_amdgcn_readfirstlane((int)F.MISC[0]);
            if (u >= 1152) break;
            if (u < 1024) gate_unit(F, 128 * (u >> 4), 128, u & 15, VN, U, args.in[15], args.in[16], MIX);
            else { const int v = u - 1024; gate_unit(F, MP + 64 * (v >> 4), 64, v & 15, VN, U, args.in[15], args.in[16], MIX); }
        }
        if (BOTH(8)) GRID_BAR();
    }
    if (IN(9)) { FRESH_IDS();
        pg8::Gemm g{MIX, WOUT, M, DM, DM}; pg8::SplitOrder S; S.init(MP, DM, F.G, (int)blockIdx.x, DM, 8, 32, 32, 16, 0);
        pg8::EpiResid<true> E{X, mod + 5 * DM, T, 1.0f, SL};
        pg8::gemm_phase<pg8::EpiResid<true>, pg8::SplitOrder, true, true>(F.lds + RING_OFF, g, S, E, F.tid);
        if (BOTH(9)) GRID_BAR();
    }
    if (IN(10)) { FRESH_IDS(); ln_rows<true, false, false>(F, T, args.in[22], args.in[23], X, mod, 6, H, SL, X + (size_t)MP * DM, mod + 5 * DM, 1.0f); if (BOTH(10)) GRID_BAR(); }
    if (IN(11)) { FRESH_IDS();
        const int GD = (F.G == 256) ? 244 : F.G;
        if ((int)blockIdx.x < GD) {
            pg8::Gemm g{H, WGU2, M, 2 * DFF, DM}; pg8::StaticOrder S; S.init(M, 2 * DFF, GD, (int)blockIdx.x, DM);
            pg8::EpiSwiglu E{ACT, DFF};
            pg8::gemm_phase<pg8::EpiSwiglu, pg8::StaticOrder, true, true>(F.lds + RING_OFF, g, S, E, F.tid);
        }
        conv_pull(F, 1, args.in, ws);
        if (BOTH(11)) GRID_BAR();
    }
    if (IN(12)) { FRESH_IDS();
        pg8::Gemm g{ACT, WD2, M, DM, DFF}; pg8::SplitOrder S; S.init(MP, DM, F.G, (int)blockIdx.x, DFF, 8, 32, 32, 16, 0);
        pg8::EpiResid<true> E{X, mod + 8 * DM, T, 0.5f, SL};
        pg8::gemm_phase<pg8::EpiResid<true>, pg8::SplitOrder, true, true>(F.lds + RING_OFF, g, S, E, F.tid);
        if (BOTH(12)) GRID_BAR();
    }
    if (IN(13)) { FRESH_IDS(); ln_rows<false, false, true>(F, T, args.in[26], args.in[27], args.out + O_Y, mod, 0, H, SL, X + (size_t)MP * DM, mod + 8 * DM, 0.5f); }
#undef IN
#undef BOTH
}

extern "C" void kernel_launch(void* const* d_in, const int* in_sizes, int n_in, void* d_out, int out_size, void* d_ws, size_t ws_size, hipStream_t stream) {
    static int grid = 0;
    if (grid == 0) {
        if (n_in != 28 || ws_size < WS_END) { fprintf(stderr, "kernel_launch: expected 28 inputs and >= %zu bytes of workspace; got %d, %zu\n", (size_t)WS_END, n_in, ws_size); grid = -1; return; }
        int dev = 0, cus = 0, per_cu = 0;
        if (hipGetDevice(&dev) != hipSuccess || hipDeviceGetAttribute(&cus, hipDeviceAttributeMultiprocessorCount, dev) != hipSuccess) { grid = -1; return; }
        if (hipFuncSetAttribute((const void*)mega_fwd, hipFuncAttributeMaxDynamicSharedMemorySize, LDS_BYTES) != hipSuccess) { fprintf(stderr, "kernel_launch: hipFuncSetAttribute failed\n"); grid = -1; return; }
        if (hipOccupancyMaxActiveBlocksPerMultiprocessor(&per_cu, (const void*)mega_fwd, NWAVES * 64, LDS_BYTES) != hipSuccess || per_cu < 1)
            fprintf(stderr, "kernel_launch: occupancy query reports %d blocks per CU\n", per_cu);
        (void)hipGetLastError();
        grid = cus;
    }
    if (grid < 0) return;
    if (hipMemsetAsync((char*)d_ws + WS_CTL, 0, CTL_ZERO_BYTES, stream) != hipSuccess) return;
    Args a{};
    for (int i = 0; i < 28; ++i) a.in[i] = (const float*)d_in[i];
    a.out = (float*)d_out; a.ws = (unsigned char*)d_ws;
#if MK_PER_PHASE
    for (int p = 0; p < N_PHASES; ++p) { a.ph_lo = p; a.ph_hi = p + 1; hipLaunchKernelGGL(mega_fwd, dim3(grid), dim3(NWAVES * 64), LDS_BYTES, stream, a); }
#else
    a.ph_lo = 0; a.ph_hi = N_PHASES; hipLaunchKernelGGL(mega_fwd, dim3(grid), dim3(NWAVES * 64), LDS_BYTES, stream, a);
#endif
    const hipError_t le = hipPeekAtLastError();
    if (le != hipSuccess) fprintf(stderr, "kernel_launch: launch failed: %s\n", hipGetErrorName(le));
}
```
